# Optimizing an MI355X kernel written in HIP

```python
import math
import jax, jax.numpy as jnp
from jax import lax
import numpy as np

D_MODEL = 2048
BATCH = 4
SEQ = 2048
DEPTH = 1

HEAD_DIM = 64
ATT_WIDTH = D_MODEL // 2
ATT_HEADS = ATT_WIDTH // HEAD_DIM
ATT_KV_HEADS = ATT_HEADS // 4
KV_WIDTH = ATT_KV_HEADS * HEAD_DIM
WINDOW = 128
ATT_BLOCK = 128
ROPE_DIM = HEAD_DIM // 4
ROPE_THETA = 500000.0
SG_WIDTH = D_MODEL // 2
SG_GROUP_DIM = 128
SG_GROUPS = SG_WIDTH // SG_GROUP_DIM
SG_CHUNK = 128
N_BRANCHES = 2
OFF_Q = 0
OFF_K = OFF_Q + ATT_WIDTH
OFF_V = OFF_K + KV_WIDTH
OFF_U = OFF_V + KV_WIDTH
OFF_S = OFF_U + SG_WIDTH
OFF_G = OFF_S + SG_WIDTH
IN_COLS = OFF_G + N_BRANCHES * D_MODEL
N_GROUPS = 8
EXPERTS_PER_GROUP = 8
N_EXPERTS = N_GROUPS * EXPERTS_PER_GROUP
TOP_K = 2
EXPERT_FF = D_MODEL // 4
MOE_BLOCK = 128
EPS = 1e-6
NEG_INF = -1e30

kernel_name = "hybrid_gated_window_gqa_spatial_gating_hmoe"


def rms_norm(x, g):
    xf = x.astype(jnp.float32)
    r = lax.rsqrt(jnp.mean(xf * xf, axis=-1, keepdims=True) + EPS)
    return (xf * r).astype(x.dtype) * g


def layer_norm(x, g, b):
    xf = x.astype(jnp.float32)
    mu = jnp.mean(xf, axis=-1, keepdims=True)
    xc = xf - mu
    var = jnp.mean(xc * xc, axis=-1, keepdims=True)
    return (xc * lax.rsqrt(var + EPS)).astype(x.dtype) * g + b


def rope_tables(positions, dtype):
    inv = ROPE_THETA ** (-jnp.arange(0, ROPE_DIM, 2, dtype=jnp.float32) / ROPE_DIM)
    ang = positions.astype(jnp.float32)[..., None] * inv
    return jnp.cos(ang)[:, :, None, :].astype(dtype), jnp.sin(ang)[:, :, None, :].astype(dtype)


def partial_rope(t, cos, sin):
    half = ROPE_DIM // 2
    r1, r2, rest = t[..., :half], t[..., half:ROPE_DIM], t[..., ROPE_DIM:]
    return jnp.concatenate([r1 * cos - r2 * sin, r2 * cos + r1 * sin, rest], axis=-1)


def window_attention(q, k, v, sink):
    B, S = q.shape[0], q.shape[1]
    nb = S // ATT_BLOCK
    G = ATT_HEADS // ATT_KV_HEADS
    qb = q.reshape(B, nb, ATT_BLOCK, ATT_KV_HEADS, G, HEAD_DIM)

    def neighbours(t):
        tp = jnp.pad(t, ((0, 0), (ATT_BLOCK, ATT_BLOCK), (0, 0), (0, 0)))
        tp = tp.reshape(B, nb + 2, ATT_BLOCK, ATT_KV_HEADS, HEAD_DIM)
        return jnp.concatenate([tp[:, :-2], tp[:, 1:-1], tp[:, 2:]], axis=2)

    kb, vb = neighbours(k), neighbours(v)
    scores = jnp.einsum('bnqhgd,bnkhd->bnhgqk', qb, kb).astype(jnp.float32) * (HEAD_DIM ** -0.5)
    qi = jnp.arange(ATT_BLOCK)[:, None]
    kj = jnp.arange(3 * ATT_BLOCK)[None, :]
    band = jnp.abs(kj - ATT_BLOCK - qi) <= WINDOW
    key_pos = jnp.arange(nb)[:, None] * ATT_BLOCK + kj - ATT_BLOCK
    in_seq = (key_pos >= 0) & (key_pos < S)
    mask = band[None, :, :] & in_seq[:, None, :]
    scores = jnp.where(mask[None, :, None, None], scores, NEG_INF)
    sink_col = jnp.broadcast_to(
        sink.astype(jnp.float32).reshape(1, 1, ATT_KV_HEADS, G, 1, 1),
        scores.shape[:-1] + (1,))
    probs = jax.nn.softmax(jnp.concatenate([scores, sink_col], axis=-1), axis=-1)[..., :-1]
    out = jnp.einsum('bnhgqk,bnkhd->bnqhgd', probs.astype(v.dtype), vb)
    return out.reshape(B, S, ATT_WIDTH)


def spatial_gating(u, s, ln_g, ln_b, w_s, b_s):
    B, S = u.shape[0], u.shape[1]
    sg = layer_norm(s.reshape(B, S, SG_GROUPS, SG_GROUP_DIM), ln_g, ln_b)
    sc = sg.reshape(B, S // SG_CHUNK, SG_CHUNK, SG_GROUPS, SG_GROUP_DIM)
    mixed = jnp.einsum('gts,bnsgc->bntgc', w_s, sc) + b_s.T[None, None, :, :, None]
    return u * mixed.reshape(B, S, SG_WIDTH)


def hierarchical_moe(x, w_group, b_group, w_erouter, b_erouter, w_gate, w_up, w_down):
    B, S, D = x.shape
    T = B * S
    xt = x.reshape(T, D)
    g_logits = (xt @ w_group).astype(jnp.float32) + b_group
    g_prob = jax.nn.softmax(g_logits, axis=-1)
    grp = jnp.argmax(g_logits, axis=-1)
    g_w = jnp.take_along_axis(g_prob, grp[:, None], axis=1)[:, 0]
    e_logits = ((xt @ w_erouter).astype(jnp.float32) + b_erouter).reshape(T, N_GROUPS, EXPERTS_PER_GROUP)
    e_logits = jnp.take_along_axis(e_logits, grp[:, None, None], axis=1)[:, 0]
    top_v, top_i = lax.top_k(e_logits, TOP_K)
    top_w = jax.nn.softmax(top_v, axis=-1) * g_w[:, None]
    expert = grp[:, None] * EXPERTS_PER_GROUP + top_i
    TK = T * TOP_K
    flat_e = expert.reshape(TK).astype(jnp.int32)
    flat_t = jnp.repeat(jnp.arange(T, dtype=jnp.int32), TOP_K)
    flat_w = top_w.reshape(TK)
    order = jnp.argsort(flat_e)
    se, st, sw = flat_e[order], flat_t[order], flat_w[order]
    counts = jnp.bincount(flat_e, length=N_EXPERTS)
    starts = jnp.cumsum(counts) - counts
    padded = (counts + MOE_BLOCK - 1) // MOE_BLOCK * MOE_BLOCK
    pad_ends = jnp.cumsum(padded)
    pad_starts = pad_ends - padded
    dest = pad_starts[se] + jnp.arange(TK) - starts[se]
    n_rows = TK + N_EXPERTS * MOE_BLOCK
    n_blocks = n_rows // MOE_BLOCK
    row_tok = jnp.full((n_rows,), T, jnp.int32).at[dest].set(st)
    row_w = jnp.zeros((n_rows,), jnp.float32).at[dest].set(sw)
    block_e = jnp.minimum(
        jnp.searchsorted(pad_ends, jnp.arange(n_blocks) * MOE_BLOCK, side='right'),
        N_EXPERTS - 1)
    xpad = jnp.concatenate([xt, jnp.zeros((1, D), xt.dtype)], axis=0)
    xrows = xpad[row_tok].reshape(n_blocks, MOE_BLOCK, D)

    def expert_block(args):
        xb, e = args
        hdn = jax.nn.silu(xb @ w_gate[e]) * (xb @ w_up[e])
        return hdn @ w_down[e]

    yrows = lax.map(expert_block, (xrows, block_e)).reshape(n_rows, D)
    yrows = yrows * row_w[:, None].astype(yrows.dtype)
    y = jax.ops.segment_sum(yrows, row_tok, num_segments=T + 1)[:T]
    return y.reshape(B, S, D)


def setup_inputs(seed: int = 0) -> dict:
    key = jax.random.key(seed)
    ks = jax.random.split(key, 24)
    f32 = jnp.float32

    def nrm(k, shape, scale):
        return jax.random.normal(k, shape, f32) * scale

    L = DEPTH
    x = jax.random.normal(ks[0], (BATCH, SEQ, D_MODEL), f32)
    offsets = jax.random.randint(ks[1], (BATCH, 1), 0, 4096, dtype=jnp.int32)
    positions = offsets + jnp.arange(SEQ, dtype=jnp.int32)[None, :]
    return {
        "x": x,
        "positions": positions,
        "norm1_g": 1.0 + nrm(ks[2], (L, D_MODEL), 0.02),
        "w_in": nrm(ks[3], (L, D_MODEL, IN_COLS), D_MODEL ** -0.5),
        "q_norm_g": 1.0 + nrm(ks[4], (L, HEAD_DIM), 0.02),
        "k_norm_g": 1.0 + nrm(ks[5], (L, HEAD_DIM), 0.02),
        "sink_logits": nrm(ks[6], (L, ATT_HEADS), 0.5),
        "sg_ln_g": 1.0 + nrm(ks[7], (L, SG_GROUPS, SG_GROUP_DIM), 0.02),
        "sg_ln_b": nrm(ks[8], (L, SG_GROUPS, SG_GROUP_DIM), 0.02),
        "sg_w": nrm(ks[9], (L, SG_GROUPS, SG_CHUNK, SG_CHUNK), SG_CHUNK ** -0.5),
        "sg_b": 1.0 + nrm(ks[10], (L, SG_GROUPS, SG_CHUNK), 0.02),
        "w_branch_att": nrm(ks[11], (L, ATT_WIDTH, D_MODEL), ATT_WIDTH ** -0.5),
        "w_branch_sg": nrm(ks[12], (L, SG_WIDTH, D_MODEL), SG_WIDTH ** -0.5),
        "w_out": nrm(ks[13], (L, D_MODEL, D_MODEL), D_MODEL ** -0.5),
        "norm2_g": 1.0 + nrm(ks[14], (L, D_MODEL), 0.02),
        "w_group_router": nrm(ks[15], (L, D_MODEL, N_GROUPS), D_MODEL ** -0.5),
        "b_group_router": nrm(ks[16], (L, N_GROUPS), 0.01),
        "w_expert_router": nrm(ks[17], (L, D_MODEL, N_EXPERTS), D_MODEL ** -0.5),
        "b_expert_router": nrm(ks[18], (L, N_EXPERTS), 0.01),
        "w_gate": nrm(ks[19], (L, N_EXPERTS, D_MODEL, EXPERT_FF), D_MODEL ** -0.5),
        "w_up": nrm(ks[20], (L, N_EXPERTS, D_MODEL, EXPERT_FF), D_MODEL ** -0.5),
        "w_down": nrm(ks[21], (L, N_EXPERTS, EXPERT_FF, D_MODEL), EXPERT_FF ** -0.5),
    }


def reference(x, positions, norm1_g, w_in, q_norm_g, k_norm_g, sink_logits, sg_ln_g, sg_ln_b,
              sg_w, sg_b, w_branch_att, w_branch_sg, w_out, norm2_g, w_group_router,
              b_group_router, w_expert_router, b_expert_router, w_gate, w_up, w_down):
    B, S, D = x.shape
    cos, sin = rope_tables(positions, x.dtype)
    h = x
    for l in range(DEPTH):
        xn = rms_norm(h, norm1_g[l])
        proj = xn @ w_in[l]
        q = proj[..., OFF_Q:OFF_K].reshape(B, S, ATT_HEADS, HEAD_DIM)
        k = proj[..., OFF_K:OFF_V].reshape(B, S, ATT_KV_HEADS, HEAD_DIM)
        v = proj[..., OFF_V:OFF_U].reshape(B, S, ATT_KV_HEADS, HEAD_DIM)
        u = jax.nn.gelu(proj[..., OFF_U:OFF_S])
        s = jax.nn.gelu(proj[..., OFF_S:OFF_G])
        gates = jax.nn.sigmoid(proj[..., OFF_G:]).reshape(B, S, N_BRANCHES, D)
        q = partial_rope(rms_norm(q, q_norm_g[l]), cos, sin)
        k = partial_rope(rms_norm(k, k_norm_g[l]), cos, sin)
        att = window_attention(q, k, v, sink_logits[l])
        sgo = spatial_gating(u, s, sg_ln_g[l], sg_ln_b[l], sg_w[l], sg_b[l])
        merged = (gates[:, :, 0, :] * (att @ w_branch_att[l])
                  + gates[:, :, 1, :] * (sgo @ w_branch_sg[l]))
        h = h + merged @ w_out[l]
        hn = rms_norm(h, norm2_g[l])
        h = h + hierarchical_moe(hn, w_group_router[l], b_group_router[l], w_expert_router[l],
                                 b_expert_router[l], w_gate[l], w_up[l], w_down[l])
    return h
```

```cpp
#include <hip/hip_runtime.h>
#include <cstdio>
#include <cstdint>
#include <cmath>

typedef _Float16 half_t;
typedef _Float16 h2_t __attribute__((ext_vector_type(2)));
typedef _Float16 h4_t __attribute__((ext_vector_type(4)));
typedef float f32x2 __attribute__((ext_vector_type(2)));
typedef float f32x4 __attribute__((ext_vector_type(4)));

constexpr int D_MODEL = 2048, BATCH = 4, SEQ = 2048, T = BATCH * SEQ;
constexpr int HEAD_DIM = 64, ATT_WIDTH = 1024, ATT_HEADS = 16, ATT_KV_HEADS = 4, KV_WIDTH = 256, WINDOW = 128;
constexpr int SG_WIDTH = 1024, SG_GROUPS = 8, SG_CHUNK = 128;
constexpr int OFF_Q = 0, OFF_K = 1024, OFF_V = 1280, OFF_U = 1536, OFF_S = 2560, OFF_G = 3584, IN_COLS = 7680;
constexpr int N_GROUPS = 8, EPG = 8, N_EXPERTS = 64, EXPERT_FF = 512;
constexpr float EPS = 1e-6f;

constexpr size_t MiB = 1u << 20;
constexpr size_t WS_CTL = 0, CTL_ZERO_BYTES = 64 * 1024;
constexpr size_t WS_COSSIN = 1 * MiB;
constexpr size_t WS_ROUTEW = 2 * MiB;
constexpr size_t WS_LIST = 3 * MiB;
constexpr size_t WS_SGW = 5 * MiB;
constexpr size_t WS_WBR = 8 * MiB, WS_WOUT = 16 * MiB, WS_WIN = 24 * MiB;
constexpr size_t WS_XN = 54 * MiB;
constexpr size_t WS_AS = 86 * MiB;
constexpr size_t WS_MERGED = 118 * MiB;
constexpr size_t WS_PROJ = 150 * MiB;
constexpr size_t WS_HID = 270 * MiB;
constexpr size_t WS_Y2 = 288 * MiB;
constexpr size_t WS_WGU = 352 * MiB, WS_WD = 608 * MiB;
constexpr size_t WS_QN = 736 * MiB;
constexpr size_t WS_KN = 768 * MiB;
constexpr size_t WS_END = 776 * MiB;
constexpr int CW_CNT = 1024;

__device__ __forceinline__ float wave_sum(float v) {
#pragma unroll
    for (int o = 1; o < 64; o <<= 1) v += __shfl_xor(v, o);
    return v;
}
__device__ __forceinline__ float wave_max(float v) {
#pragma unroll
    for (int o = 1; o < 64; o <<= 1) v = fmaxf(v, __shfl_xor(v, o));
    return v;
}
__device__ __forceinline__ float gelu_tanh(float x) {
    const float u = 0.7978845608028654f * (x + 0.044715f * x * x * x);
    return x / (1.f + __expf(-2.f * u));
}
__device__ __forceinline__ float sigmoidf_(float x) { return 1.f / (1.f + __expf(-x)); }

#define LAS __attribute__((address_space(3)))
#define GAS __attribute__((address_space(1)))
typedef _Float16 h8_t __attribute__((ext_vector_type(8)));
typedef unsigned u32x4 __attribute__((ext_vector_type(4)));
typedef unsigned u32x2 __attribute__((ext_vector_type(2)));
typedef float f32x16 __attribute__((ext_vector_type(16)));
typedef short s16x4 __attribute__((ext_vector_type(4)));
typedef int i32x4 __attribute__((ext_vector_type(4)));
__device__ __forceinline__ __amdgpu_buffer_rsrc_t mk_rsrc(const void* p, unsigned bytes) { return __builtin_amdgcn_make_buffer_rsrc((void*)p, (short)0, (int)bytes, 0x00020000); }
__device__ __forceinline__ void st16_wt(__amdgpu_buffer_rsrc_t r, unsigned byte_off, u32x4 v) { __builtin_amdgcn_raw_buffer_store_b128(v, r, byte_off, 0, 16); }

constexpr size_t WS_RSTD2 = 2 * MiB + 128 * 1024;
constexpr size_t WS_ROWSS = 6 * MiB;
constexpr size_t WS_WRT = 7 * MiB;
constexpr size_t WS_XN8 = WS_WGU;
constexpr size_t WS_W8 = WS_WGU + 16 * MiB;
constexpr size_t WS_SA = 2 * MiB + 192 * 1024;
constexpr size_t WS_SW = 2 * MiB + 224 * 1024;
constexpr size_t WS_RSE = WS_XN;
constexpr size_t WS_RWE = WS_XN + 2 * MiB;
constexpr size_t WS_H16 = WS_QN;
constexpr int NWAVES = 8;
constexpr int RING_BYTES = 131072, MISC_OFF = 147456, LDS_BYTES = 151552;
constexpr int MI_BAR = 0, MI_MT = 16, MI_OFFS = 144, MI_CNT = 208, MI_NT = 272, MI_SW = 280;
constexpr int CW_BAR = 4096, CW_CNT2 = 8192;

__device__ __forceinline__ unsigned pkh(float lo, float hi) { f32x2 v = {lo, hi}; h2_t h = __builtin_convertvector(v, h2_t); return __builtin_bit_cast(unsigned, h); }
__device__ __forceinline__ unsigned pk4_fp8(float a, float b, float c, float d) { int w = 0; w = __builtin_amdgcn_cvt_pk_fp8_f32(a, b, w, false); w = __builtin_amdgcn_cvt_pk_fp8_f32(c, d, w, true); return (unsigned)w; }
__device__ __forceinline__ float fast_exp2(float x) { return __builtin_amdgcn_exp2f(x); }
__device__ __forceinline__ float fast_rcp(float x) { return __builtin_amdgcn_rcpf(x); }
__device__ __forceinline__ float gelu_f(float x) { const float u = x + 0.044715f * x * x * x; return x * fast_rcp(1.f + fast_exp2(-2.302208198f * u)); }
__device__ __forceinline__ float sigm_f(float x) { return fast_rcp(1.f + fast_exp2(-1.4426950409f * x)); }

#define XB_TMO      128
#define XB_XCNT(j)  (256  + 64 * (j))
#define XB_XSUB(j)  (1280 + 64 * (j))
#define XB_XGEN(j)  (2304 + 64 * (j))
#define XB_TOP      3328
#define XB_TOPGEN   3392
#define XCD_BAR_WORDS 3456
#define XB_SPIN_CAP (1u << 18)
__device__ __forceinline__ unsigned xb_ld(unsigned* p)              { return __hip_atomic_load(p, __ATOMIC_RELAXED, __HIP_MEMORY_SCOPE_AGENT); }
__device__ __forceinline__ unsigned xb_add(unsigned* p, unsigned v) { return __hip_atomic_fetch_add(p, v, __ATOMIC_RELAXED, __HIP_MEMORY_SCOPE_AGENT); }
__device__ __forceinline__ unsigned xb_xcc_id() { return (unsigned)__builtin_amdgcn_s_getreg((3 << 11) | 20) & 0xFu; }
#define XB_SPIN(cond, bar) do { unsigned _sp = 0; while (cond) { __builtin_amdgcn_s_sleep(1); \
    if ((++_sp & 255u) == 0u) { if (xb_ld(&(bar)[XB_TMO])) break; if (_sp > XB_SPIN_CAP) { atomicAdd(&(bar)[XB_TMO], 1u); break; } } } } while (0)
struct XcdBarrier { unsigned* bar; unsigned x; volatile LAS unsigned* st; };
__device__ __forceinline__ XcdBarrier xcd_barrier_post(unsigned* bar, volatile LAS unsigned* st) {
    XcdBarrier b; b.bar = bar; b.x = xb_xcc_id(); b.st = st;
    if (threadIdx.x == 0) (void)xb_add(&bar[XB_XCNT(b.x)], 1u);
    return b;
}
__device__ __forceinline__ void xcd_barrier_complete(unsigned* bar, unsigned x, unsigned& nloc, unsigned& nx) {
    const unsigned G = gridDim.x * gridDim.y * gridDim.z;
    unsigned sum, cnt, mine, sp = 0u;
    for (;;) {
        sum = 0u; cnt = 0u; mine = 0u;
#pragma unroll
        for (unsigned j = 0; j < 16; ++j) { const unsigned c = xb_ld(&bar[XB_XCNT(j)]); sum += c; cnt += (c > 0u) ? 1u : 0u; mine = (j == x) ? c : mine; }
        if (sum == G) break;
        __builtin_amdgcn_s_sleep(1);
        if ((++sp & 255u) == 0u) { if (xb_ld(&bar[XB_TMO])) break; if (sp > XB_SPIN_CAP) { atomicAdd(&bar[XB_TMO], 1u); break; } }
    }
    nloc = mine > 0u ? mine : 1u; nx = cnt > 0u ? cnt : 1u;
}
__device__ __forceinline__ void xcd_barrier(const XcdBarrier& b) {
    asm volatile("s_waitcnt vmcnt(0)" ::: "memory");
    __syncthreads();
    if (threadIdx.x == 0) {
        unsigned* bar = b.bar;
        __builtin_amdgcn_s_waitcnt(0);
        unsigned nloc = b.st[0], nx = b.st[1];
        if (nloc == 0u) { xcd_barrier_complete(bar, b.x, nloc, nx); b.st[0] = nloc; b.st[1] = nx; }
        const unsigned old = xb_add(&bar[XB_XSUB(b.x)], 1u);
        const unsigned gen = old / nloc;
        if (old + 1u == (gen + 1u) * nloc) {
            __builtin_amdgcn_fence(__ATOMIC_RELEASE, "agent");
            asm volatile("s_waitcnt vmcnt(0)" ::: "memory");
            const unsigned og = xb_add(&bar[XB_TOP], 1u);
            const unsigned tg = og / nx;
            if (og + 1u == (tg + 1u) * nx) xb_add(&bar[XB_TOPGEN], 1u);
            else XB_SPIN(xb_ld(&bar[XB_TOPGEN]) == tg, bar);
            __builtin_amdgcn_fence(__ATOMIC_ACQUIRE, "agent");
            xb_add(&bar[XB_XGEN(b.x)], 1u);
            asm volatile("s_waitcnt vmcnt(0)" ::: "memory");
        } else {
            XB_SPIN(xb_ld(&bar[XB_XGEN(b.x)]) == gen, bar);
            __builtin_amdgcn_fence(__ATOMIC_ACQUIRE, "agent");
            asm volatile("s_waitcnt vmcnt(0)" ::: "memory");
        }
    }
    __syncthreads();
}

namespace pg {
constexpr int BM = 256, BK = 64, HALF = 128, HTB = HALF * BK * 2, STAGE_BYTES = 8 * HTB;
__device__ __forceinline__ int lds_byte(int r, int c) { const int st = (r >> 4) * 2 + (c >> 5), rr = r & 15, cc = c & 31, ob = rr * 64 + cc * 2; return st * 1024 + (ob ^ (((ob >> 9) & 1) << 5)); }
__device__ __forceinline__ void stage_rc(int b, int& R, int& C) { const int st = b / 1024, sb = b % 1024, swz = sb ^ (((sb >> 9) & 1) << 5); R = (st >> 1) * 16 + swz / 64; C = (st & 1) * 32 + (swz % 64) / 2; }
__device__ __forceinline__ int perm32(int rho) { const int n = rho >> 4, i = rho & 15; return 8 * (i >> 2) + 4 * n + (i & 3); }
typedef f32x4 Acc[2][2][4][2];

template <class P, bool ALIGN_EPI>
__device__ __forceinline__ void gemm_phase(LAS unsigned char* lds, const P& S) {
    const int tid = threadIdx.x, wid = __builtin_amdgcn_readfirstlane(tid >> 6), lane = tid & 63, wr = wid >> 2, wc = wid & 3, fr = lane & 15, fq = lane >> 4;
    const int nt = S.nt;
    int R[2], C[2]; unsigned voffB[2][2];
#pragma unroll
    for (int i = 0; i < 2; ++i) { stage_rc(tid * 16 + i * 8192, R[i], C[i]); const int Rb = P::PERM ? ((R[i] & ~31) + perm32(R[i] & 31)) : R[i];
#pragma unroll
        for (int h = 0; h < 2; ++h) voffB[h][i] = (unsigned)(((h * HALF + Rb) * S.ldb + C[i]) * 2); }
    const unsigned ldsw = (unsigned)wid * 1024u;
    const int aoff = lds_byte(wr * 64 + fr, fq * 8), boff = lds_byte(wc * 32 + fr, fq * 8);
#define PG_SA(b, h) (((b) * 2 + (h)) * HTB)
#define PG_SB(b, h) ((4 + (b) * 2 + (h)) * HTB)
#define PG_STAGE(bufoff, gbase, voff) do { _Pragma("unroll") for (int _i = 0; _i < 2; ++_i) \
        __builtin_amdgcn_global_load_lds((const unsigned*)((const char*)(gbase) + (voff)[_i]), (LAS unsigned*)(lds + (bufoff) + ldsw + _i * 8192), 16, 0, 0); } while (0)
#define PG_LDA(dst, b, h) do { _Pragma("unroll") for (int m = 0; m < 4; ++m) _Pragma("unroll") for (int k = 0; k < 2; ++k) dst[m][k] = *(const LAS h8_t*)(lds + PG_SA(b, h) + aoff + m * 2048 + k * 1024); } while (0)
#define PG_LDB(dst, b, h) do { _Pragma("unroll") for (int n = 0; n < 2; ++n) _Pragma("unroll") for (int k = 0; k < 2; ++k) dst[n][k] = *(const LAS h8_t*)(lds + PG_SB(b, h) + boff + n * 2048 + k * 1024); } while (0)
#define PG_MMA(ai, bj, At, Bt) do { __builtin_amdgcn_s_setprio(1); _Pragma("unroll") for (int m = 0; m < 4; ++m) _Pragma("unroll") for (int n = 0; n < 2; ++n) _Pragma("unroll") for (int k = 0; k < 2; ++k) \
        { if constexpr (P::I8) acc[ai][bj][m][n] = __builtin_bit_cast(f32x4, __builtin_amdgcn_mfma_i32_16x16x64_i8(__builtin_bit_cast(i32x4, Bt[n][k]), __builtin_bit_cast(i32x4, At[m][k]), __builtin_bit_cast(i32x4, acc[ai][bj][m][n]), 0, 0, 0)); \
          else acc[ai][bj][m][n] = __builtin_amdgcn_mfma_f32_16x16x32_f16(Bt[n][k], At[m][k], acc[ai][bj][m][n], 0, 0, 0); } __builtin_amdgcn_s_setprio(0); } while (0)
#define PG_WAIT_V(n) asm volatile("s_waitcnt vmcnt(" #n ")" ::: "memory")
#define PG_WAIT_L(n) asm volatile("s_waitcnt lgkmcnt(" #n ")" ::: "memory")
#define PG_BAR __builtin_amdgcn_s_barrier()
#define PG_SCHED __builtin_amdgcn_sched_barrier(0)
    typename P::Unit cur, nxt; int ui = 0;
    if (!S.next(0, cur)) return;
    Acc acc;
#pragma unroll
    for (int a = 0; a < 2; ++a)
#pragma unroll
        for (int b = 0; b < 2; ++b)
#pragma unroll
            for (int m = 0; m < 4; ++m)
#pragma unroll
                for (int n = 0; n < 2; ++n) acc[a][b][m][n] = (f32x4){0.f, 0.f, 0.f, 0.f};
    h8_t At[4][2], B0[2][2], B1[2][2];
    unsigned voffA[2][2];
    const char* cA = S.a_ptr(cur); const char* cB = S.b_ptr(cur);
    S.a_voff(cur, R, C, voffA);
    constexpr size_t kstep = (size_t)(BK * 2);
    PG_STAGE(PG_SB(0, 0), cB, voffB[0]); PG_STAGE(PG_SB(0, 1), cB, voffB[1]); PG_STAGE(PG_SA(0, 0), cA, voffA[0]); PG_STAGE(PG_SA(0, 1), cA, voffA[1]);
    if (wr == 1) PG_BAR;
    PG_WAIT_V(2); PG_BAR;
    PG_STAGE(PG_SB(1, 0), cB + kstep, voffB[0]); PG_STAGE(PG_SA(1, 0), cA + kstep, voffA[0]); PG_STAGE(PG_SB(1, 1), cB + kstep, voffB[1]);
    PG_WAIT_V(6); PG_BAR;
    for (;;) {
        const bool has_next = S.next(ui + 1, nxt);
        const char* nA = has_next ? S.a_ptr(nxt) : cA; const char* nB = has_next ? S.b_ptr(nxt) : cB;
        for (int t = 0; t < nt; t += 2) {
            const bool last = (t == nt - 2);
            if (P::MIDT >= 0 && t == P::MIDT) S.mid(acc, cur, wr, wc, fr, fq);
            const char* a1 = cA + (size_t)(t + 1) * kstep;
            const char* a2 = last ? nA : cA + (size_t)(t + 2) * kstep; const char* b2 = last ? nB : cB + (size_t)(t + 2) * kstep;
            const char* a3 = a2 + kstep; const char* b3 = b2 + kstep;
            PG_LDB(B0, 0, 0); PG_LDB(B1, 0, 1); PG_SCHED; PG_LDA(At, 0, 0); PG_STAGE(PG_SA(1, 1), a1, voffA[1]);
            PG_WAIT_V(8); PG_WAIT_L(0); PG_BAR; PG_MMA(0, 0, At, B0); PG_MMA(0, 1, At, B1); PG_BAR; PG_SCHED;
            if (last && has_next) S.a_voff(nxt, R, C, voffA);
            PG_LDA(At, 0, 1); PG_STAGE(PG_SB(0, 0), b2, voffB[0]); PG_STAGE(PG_SB(0, 1), b2, voffB[1]); PG_STAGE(PG_SA(0, 0), a2, voffA[0]);
            PG_WAIT_V(8); PG_WAIT_L(0); PG_BAR; PG_MMA(1, 0, At, B0); PG_MMA(1, 1, At, B1); PG_BAR; PG_SCHED;
            PG_LDB(B0, 1, 0); PG_LDB(B1, 1, 1); PG_SCHED; PG_LDA(At, 1, 0); PG_STAGE(PG_SA(0, 1), a2, voffA[1]);
            PG_WAIT_V(8); PG_WAIT_L(0); PG_BAR; PG_MMA(0, 0, At, B0); PG_MMA(0, 1, At, B1); PG_BAR; PG_SCHED;
            PG_LDA(At, 1, 1); PG_STAGE(PG_SB(1, 0), b3, voffB[0]); PG_STAGE(PG_SB(1, 1), b3, voffB[1]); PG_STAGE(PG_SA(1, 0), a3, voffA[0]);
            PG_WAIT_V(8); PG_WAIT_L(0); PG_BAR; PG_MMA(1, 0, At, B0); PG_MMA(1, 1, At, B1); PG_BAR; PG_SCHED;
        }
        if constexpr (ALIGN_EPI) { if (wr == 0) PG_BAR; }
        S.epi(acc, cur, wr, wc, fr, fq);
        if (!has_next) break;
#pragma unroll
        for (int a = 0; a < 2; ++a)
#pragma unroll
            for (int b = 0; b < 2; ++b)
#pragma unroll
                for (int m = 0; m < 4; ++m)
#pragma unroll
                    for (int n = 0; n < 2; ++n) acc[a][b][m][n] = (f32x4){0.f, 0.f, 0.f, 0.f};
        cur = nxt; cA = nA; cB = nB; ++ui;
        if constexpr (ALIGN_EPI) { if (wr == 1) PG_BAR; }
    }
    PG_WAIT_V(0);
    if constexpr (!ALIGN_EPI) { if (wr == 0) PG_BAR; }
    PG_BAR;
#undef PG_SA
#undef PG_SB
#undef PG_STAGE
#undef PG_LDA
#undef PG_LDB
#undef PG_MMA
#undef PG_WAIT_V
#undef PG_WAIT_L
#undef PG_BAR
#undef PG_SCHED
}

struct DenseOrder {
    int nM, nN, nwg, G, c;
    __device__ void init(int M, int N, int G_, int c_) { nM = M / BM; nN = N / BM; nwg = nM * nN; G = G_; c = c_; }
    __device__ bool next(int i, int& pm, int& pn) const {
        const long L = (long)i * G + c; if (L >= nwg) return false;
        int wgid = (int)L; { const int q = nwg / 8, r = nwg % 8, xcd = wgid % 8, off = wgid / 8; wgid = (xcd < r ? xcd * (q + 1) : r * (q + 1) + (xcd - r) * q) + off; }
        const int nig = 8 * nN, gid = wgid / nig, fm = gid * 8, gsz = (nM - fm) < 8 ? (nM - fm) : 8;
        pm = fm + ((wgid % nig) % gsz); pn = (wgid % nig) / gsz; return true;
    }
};
struct DUnit { int pm, pn; };
}

struct Frame {
    LAS unsigned char* lds; volatile LAS unsigned* MISC; unsigned* ctl;
    int tid, lane, wave, vcu, G;
    const float* in[22]; float* out; unsigned char* ws;
};

__host__ __device__ __forceinline__ bool attn_only_tile(int) { return true; }
__device__ __forceinline__ unsigned pk4_i8(float a, float b, float c, float d) {
    const int q0 = (int)__builtin_rintf(fminf(fmaxf(a, -127.f), 127.f)), q1 = (int)__builtin_rintf(fminf(fmaxf(b, -127.f), 127.f)), q2 = (int)__builtin_rintf(fminf(fmaxf(c, -127.f), 127.f)), q3 = (int)__builtin_rintf(fminf(fmaxf(d, -127.f), 127.f));
    return (unsigned)(q0 & 255) | ((unsigned)(q1 & 255) << 8) | ((unsigned)(q2 & 255) << 16) | ((unsigned)q3 << 24); }
struct ProjProbI8 {
    typedef pg::DUnit Unit; static constexpr bool I8 = true; static constexpr bool PERM = true; static constexpr int MIDT = -1;
    int nt, ldb; pg::DenseOrder ord; const unsigned char* A; const unsigned char* Bt; half_t* O; const float* SA; float sW;
    __device__ __forceinline__ bool next(int i, Unit& u) const { return ord.next(i, u.pm, u.pn); }
    __device__ __forceinline__ const char* a_ptr(const Unit& u) const { return (const char*)A + (size_t)u.pm * 256 * D_MODEL; }
    __device__ __forceinline__ const char* b_ptr(const Unit& u) const { return (const char*)Bt + (size_t)u.pn * 256 * D_MODEL; }
    __device__ __forceinline__ void a_voff(const Unit&, const int (&R)[2], const int (&C)[2], unsigned (&v)[2][2]) const {
#pragma unroll
        for (int h = 0; h < 2; ++h)
#pragma unroll
            for (int i = 0; i < 2; ++i) v[h][i] = (unsigned)(((h * 128 + R[i]) * (D_MODEL / 2) + C[i]) * 2); }
    __device__ __forceinline__ void mid(pg::Acc&, const Unit&, int, int, int, int) const {}
    __device__ __forceinline__ void epi(pg::Acc& acc, const Unit& u, int wr, int wc, int fr, int fq) const {
        const bool gate = u.pn >= 14, gel = u.pn >= 6 && u.pn < 14;
        const int row0 = u.pm * 256 + wr * 64 + fr, col0 = u.pn * 256 + wc * 32 + 8 * fq;
        float scl[2][4];
#pragma unroll
        for (int ai = 0; ai < 2; ++ai)
#pragma unroll
            for (int m = 0; m < 4; ++m) scl[ai][m] = SA[row0 + ai * 128 + m * 16] * sW;
#pragma unroll
        for (int ai = 0; ai < 2; ++ai)
#pragma unroll
            for (int m = 0; m < 4; ++m) { const int row = row0 + ai * 128 + m * 16; half_t* rowp = O + (size_t)row * IN_COLS + col0; const float sc = scl[ai][m];
#pragma unroll
                for (int bj = 0; bj < 2; ++bj) { const i32x4 i0 = __builtin_bit_cast(i32x4, acc[ai][bj][m][0]), i1 = __builtin_bit_cast(i32x4, acc[ai][bj][m][1]);
                    f32x4 v0 = (f32x4){(float)i0[0], (float)i0[1], (float)i0[2], (float)i0[3]} * sc, v1 = (f32x4){(float)i1[0], (float)i1[1], (float)i1[2], (float)i1[3]} * sc;
                    if (gate) {
#pragma unroll
                        for (int e = 0; e < 4; ++e) { v0[e] = sigm_f(v0[e]); v1[e] = sigm_f(v1[e]); } }
                    else if (gel) {
#pragma unroll
                        for (int e = 0; e < 4; ++e) { v0[e] = gelu_f(v0[e]); v1[e] = gelu_f(v1[e]); } }
                    u32x4 w; w.x = pkh(v0[0], v0[1]); w.y = pkh(v0[2], v0[3]); w.z = pkh(v1[0], v1[1]); w.w = pkh(v1[2], v1[3]);
                    *(u32x4*)(rowp + bj * 128) = w; } }
    }
};

struct MergeProb {
    typedef pg::DUnit Unit; static constexpr bool I8 = false; static constexpr bool PERM = true; static constexpr int MIDT = 16;
    int nt, ldb; pg::DenseOrder ord; const half_t* A; const half_t* Bt; const half_t* PROJ; half_t* O;
    __device__ __forceinline__ bool next(int i, Unit& u) const { return ord.next(i, u.pm, u.pn); }
    __device__ __forceinline__ const char* a_ptr(const Unit& u) const { return (const char*)A + (size_t)u.pm * 256 * D_MODEL * 2; }
    __device__ __forceinline__ const char* b_ptr(const Unit& u) const { return (const char*)Bt + (size_t)u.pn * 256 * D_MODEL * 2; }
    __device__ __forceinline__ void a_voff(const Unit&, const int (&R)[2], const int (&C)[2], unsigned (&v)[2][2]) const {
#pragma unroll
        for (int h = 0; h < 2; ++h)
#pragma unroll
            for (int i = 0; i < 2; ++i) v[h][i] = (unsigned)(((h * 128 + R[i]) * D_MODEL + C[i]) * 2); }
    __device__ __forceinline__ void mid(pg::Acc& acc, const Unit& u, int wr, int wc, int fr, int fq) const {
        int row0 = u.pm * 256 + wr * 64 + fr; const int col0 = u.pn * 256 + wc * 32 + 8 * fq;
        asm volatile("" : "+v"(row0));
        h8_t ga[2][2], gb[2][2];
#define MP_LOADG(dst, g_) do { const half_t* gp_ = PROJ + (size_t)(row0 + ((g_) >> 2) * 128 + ((g_) & 3) * 16) * IN_COLS + OFF_G + col0; \
            _Pragma("unroll") for (int bj = 0; bj < 2; ++bj) { dst[bj][0] = *(const h8_t*)(gp_ + bj * 128); dst[bj][1] = *(const h8_t*)(gp_ + D_MODEL + bj * 128); } } while (0)
#define MP_SCALE(src, g_) do { const int ai = (g_) >> 2, m = (g_) & 3; _Pragma("unroll") for (int bj = 0; bj < 2; ++bj) { _Pragma("unroll") for (int e = 0; e < 4; ++e) { \
            acc[ai][bj][m][0][e] *= (float)src[bj][0][e] * fast_rcp((float)src[bj][1][e]); acc[ai][bj][m][1][e] *= (float)src[bj][0][4 + e] * fast_rcp((float)src[bj][1][4 + e]); } } } while (0)
        MP_LOADG(ga, 0);
#pragma unroll
        for (int g = 0; g < 8; g += 2) {
            MP_LOADG(gb, g + 1); asm volatile("" ::: "memory"); MP_SCALE(ga, g); asm volatile("" ::: "memory");
            if (g + 2 < 8) MP_LOADG(ga, g + 2); asm volatile("" ::: "memory"); MP_SCALE(gb, g + 1); asm volatile("" ::: "memory");
        }
#undef MP_SCALE
    }
    __device__ __forceinline__ void epi(pg::Acc& acc, const Unit& u, int wr, int wc, int fr, int fq) const {
        const int row0 = u.pm * 256 + wr * 64 + fr, col0 = u.pn * 256 + wc * 32 + 8 * fq;
        h8_t ga[2][2], gb[2][2];
#define MP_STORE(src, g_) do { const int ai = (g_) >> 2, m = (g_) & 3; const size_t row = (size_t)(row0 + ai * 128 + m * 16); _Pragma("unroll") for (int bj = 0; bj < 2; ++bj) { \
            const h8_t g1 = src[bj][1]; const f32x4 v0 = acc[ai][bj][m][0], v1 = acc[ai][bj][m][1]; \
            u32x4 w; w.x = pkh(v0[0] * (float)g1[0], v0[1] * (float)g1[1]); w.y = pkh(v0[2] * (float)g1[2], v0[3] * (float)g1[3]); \
            w.z = pkh(v1[0] * (float)g1[4], v1[1] * (float)g1[5]); w.w = pkh(v1[2] * (float)g1[6], v1[3] * (float)g1[7]); \
            *(u32x4*)(O + row * D_MODEL + col0 + bj * 128) = w; } } while (0)
        MP_LOADG(ga, 0);
#pragma unroll
        for (int g = 0; g < 8; g += 2) {
            MP_LOADG(gb, g + 1); asm volatile("" ::: "memory"); MP_STORE(ga, g); asm volatile("" ::: "memory");
            if (g + 2 < 8) MP_LOADG(ga, g + 2); asm volatile("" ::: "memory"); MP_STORE(gb, g + 1); asm volatile("" ::: "memory");
        }
#undef MP_STORE
#undef MP_LOADG
    }
};

struct OutProb {
    typedef pg::DUnit Unit; static constexpr bool I8 = false; static constexpr bool PERM = true; static constexpr int MIDT = -1;
    int nt, ldb; pg::DenseOrder ord; const half_t* A; const half_t* Bt; const float* x; const float* g2; float* out; half_t* H16; float* ROWSS;
    __device__ __forceinline__ bool next(int i, Unit& u) const { return ord.next(i, u.pm, u.pn); }
    __device__ __forceinline__ const char* a_ptr(const Unit& u) const { return (const char*)A + (size_t)u.pm * 256 * D_MODEL * 2; }
    __device__ __forceinline__ const char* b_ptr(const Unit& u) const { return (const char*)Bt + (size_t)u.pn * 256 * D_MODEL * 2; }
    __device__ __forceinline__ void a_voff(const Unit&, const int (&R)[2], const int (&C)[2], unsigned (&v)[2][2]) const {
#pragma unroll
        for (int h = 0; h < 2; ++h)
#pragma unroll
            for (int i = 0; i < 2; ++i) v[h][i] = (unsigned)(((h * 128 + R[i]) * D_MODEL + C[i]) * 2); }
    __device__ __forceinline__ void mid(pg::Acc&, const Unit&, int, int, int, int) const {}
    __device__ __forceinline__ void epi(pg::Acc& acc, const Unit& u, int wr, int wc, int fr, int fq) const {
        const int row0 = u.pm * 256 + wr * 64 + fr, col0 = u.pn * 256 + wc * 32 + 8 * fq;
        f32x4 gg[2][2];
#pragma unroll
        for (int bj = 0; bj < 2; ++bj)
#pragma unroll
            for (int n = 0; n < 2; ++n) gg[bj][n] = *(const f32x4*)(g2 + col0 + bj * 128 + n * 4);
        f32x4 xq[4][2][2];
#define OP_LOADX(dst, g_) do { const size_t r_ = (size_t)(row0 + ((g_) >> 2) * 128 + ((g_) & 3) * 16) * D_MODEL + col0; _Pragma("unroll") for (int bj = 0; bj < 2; ++bj) _Pragma("unroll") for (int n = 0; n < 2; ++n) dst[bj][n] = *(const f32x4*)(x + r_ + bj * 128 + n * 4); } while (0)
#define OP_GROUP(src, g_) do { const int ai = (g_) >> 2, m = (g_) & 3; const size_t row = (size_t)(row0 + ai * 128 + m * 16); float ss = 0.f; \
            _Pragma("unroll") for (int bj = 0; bj < 2; ++bj) { const size_t off = row * D_MODEL + col0 + bj * 128; \
                const f32x4 h0 = src[bj][0] + acc[ai][bj][m][0], h1 = src[bj][1] + acc[ai][bj][m][1]; \
                ss += ((h0[0] * h0[0] + h0[1] * h0[1]) + (h0[2] * h0[2] + h0[3] * h0[3])) + ((h1[0] * h1[0] + h1[1] * h1[1]) + (h1[2] * h1[2] + h1[3] * h1[3])); \
                u32x4 w; w.x = pkh(h0[0] * gg[bj][0][0], h0[1] * gg[bj][0][1]); w.y = pkh(h0[2] * gg[bj][0][2], h0[3] * gg[bj][0][3]); \
                w.z = pkh(h1[0] * gg[bj][1][0], h1[1] * gg[bj][1][1]); w.w = pkh(h1[2] * gg[bj][1][2], h1[3] * gg[bj][1][3]); *(u32x4*)(H16 + off) = w; } \
            ss += __shfl_xor(ss, 16); ss += __shfl_xor(ss, 32); if (fq == 0) ROWSS[row * 32 + u.pn * 4 + wc] = ss; } while (0)
#pragma unroll
        for (int g = 0; g < 4; ++g) OP_LOADX(xq[g], g);
        asm volatile("" ::: "memory");
#pragma unroll
        for (int g = 0; g < 8; ++g) {
            OP_GROUP(xq[g & 3], g); asm volatile("" ::: "memory");
            if (g + 4 < 8) OP_LOADX(xq[g & 3], g + 4); asm volatile("" ::: "memory");
        }
#undef OP_LOADX
#undef OP_GROUP
    }
};

template <bool Q8>
__device__ __forceinline__ void p0_item(const float* W, int N, void* dstv, int ldt, float qscale, LAS float* scr, int k0, int n0, int dst_row0, int lane) {
    { const int kk = lane >> 3, c4 = lane & 7;
      f32x4 v[8];
#pragma unroll
      for (int i = 0; i < 8; ++i) v[i] = *(const f32x4*)(W + (size_t)(k0 + 8 * i + kk) * N + n0 + 4 * c4);
#pragma unroll
      for (int i = 0; i < 8; ++i) { const f32x4 x = v[i]; LAS float* p = scr + (8 * i + kk) * 33 + 4 * c4; p[0] = x[0]; p[1] = x[1]; p[2] = x[2]; p[3] = x[3]; } }
    asm volatile("s_waitcnt lgkmcnt(0)" ::: "memory");
    const int c = lane & 7;
#pragma unroll
    for (int j = 0; j < 4; ++j) { const int n = (lane >> 3) + 8 * j; const LAS float* s = scr + (8 * c) * 33 + n;
        if constexpr (Q8) { u32x2 o; o.x = pk4_i8(s[0 * 33] * qscale, s[1 * 33] * qscale, s[2 * 33] * qscale, s[3 * 33] * qscale); o.y = pk4_i8(s[4 * 33] * qscale, s[5 * 33] * qscale, s[6 * 33] * qscale, s[7 * 33] * qscale);
            *(u32x2*)((unsigned char*)dstv + (size_t)(dst_row0 + n) * ldt + k0 + 8 * c) = o; }
        else { u32x4 o; o.x = pkh(s[0 * 33], s[1 * 33]); o.y = pkh(s[2 * 33], s[3 * 33]); o.z = pkh(s[4 * 33], s[5 * 33]); o.w = pkh(s[6 * 33], s[7 * 33]);
            *(u32x4*)((half_t*)dstv + (size_t)(dst_row0 + n) * ldt + k0 + 8 * c) = o; } }
    asm volatile("s_waitcnt lgkmcnt(0)" ::: "memory");
}
__device__ __forceinline__ void p0_prologue(Frame& F) {
    LAS float* scr = (LAS float*)(F.lds + F.wave * 16384);
    const int gw = F.vcu * NWAVES + F.wave, NGW = F.G * NWAVES, lane = F.lane;
    unsigned char* ws = F.ws;
    half_t* WIN_T = (half_t*)(ws + WS_WIN); unsigned char* W8 = ws + WS_W8;
    if (F.wave == 0) { float ss = 0.f;
#pragma unroll
        for (int r = 0; r < 2; ++r)
#pragma unroll
            for (int j = 0; j < 4; ++j) { const f32x4 v = *(const f32x4*)(F.in[3] + (size_t)r * IN_COLS + 4 * lane + 256 * j); ss += (v[0] * v[0] + v[1] * v[1]) + (v[2] * v[2] + v[3] * v[3]); }
        ss = wave_sum(ss); const float sw = 4.f * sqrtf(ss * (1.f / 2048.f)) * (1.f / 127.f);
        if (lane == 0) { ((LAS float*)F.MISC)[MI_SW] = sw; if (blockIdx.x == 0) *(float*)(ws + WS_SW) = sw; } }
    __syncthreads();
    const float inv_sw = 1.f / ((volatile LAS float*)F.MISC)[MI_SW];
    constexpr int I_IN = 32 * 240;
    for (int it = gw; it < I_IN; it += NGW) { const int kb = it / 240, nb = it % 240;
        if (attn_only_tile(nb >> 3)) p0_item<true>(F.in[3], IN_COLS, W8, D_MODEL, inv_sw, scr, 64 * kb, 32 * nb, 32 * nb, lane);
        else p0_item<false>(F.in[3], IN_COLS, WIN_T, D_MODEL, 1.f, scr, 64 * kb, 32 * nb, 32 * nb, lane); }
    { const float* x = F.in[0]; const float* g1 = F.in[2]; half_t* XN = (half_t*)(ws + WS_XN);
      for (int m = gw; m < T; m += 2 * NGW) { const int m2 = min(m + NGW, T - 1);
          const f32x4* xr = (const f32x4*)(x + (size_t)m * D_MODEL) + lane; const f32x4* xr2 = (const f32x4*)(x + (size_t)m2 * D_MODEL) + lane; f32x4 v[8], v2[8]; float s = 0.f, s2 = 0.f;
#pragma unroll
          for (int j = 0; j < 8; ++j) { v[j] = xr[64 * j]; v2[j] = xr2[64 * j]; }
#pragma unroll
          for (int j = 0; j < 8; ++j) { s += (v[j][0] * v[j][0] + v[j][1] * v[j][1]) + (v[j][2] * v[j][2] + v[j][3] * v[j][3]); s2 += (v2[j][0] * v2[j][0] + v2[j][1] * v2[j][1]) + (v2[j][2] * v2[j][2] + v2[j][3] * v2[j][3]); }
          const float r = rsqrtf(wave_sum(s) * (1.f / D_MODEL) + EPS), r2 = rsqrtf(wave_sum(s2) * (1.f / D_MODEL) + EPS);
          u32x2* o8 = (u32x2*)(XN + (size_t)m * D_MODEL) + lane; u32x2* o82 = (u32x2*)(XN + (size_t)m2 * D_MODEL) + lane;
          float am = 0.f, am2 = 0.f;
#pragma unroll
          for (int j = 0; j < 8; ++j) { const f32x4 g = ((const f32x4*)g1)[lane + 64 * j]; v[j] = v[j] * r * g; v2[j] = v2[j] * r2 * g;
              am = fmaxf(am, fmaxf(fmaxf(fabsf(v[j][0]), fabsf(v[j][1])), fmaxf(fabsf(v[j][2]), fabsf(v[j][3])))); am2 = fmaxf(am2, fmaxf(fmaxf(fabsf(v2[j][0]), fabsf(v2[j][1])), fmaxf(fabsf(v2[j][2]), fabsf(v2[j][3])))); }
          am = fmaxf(wave_max(am), 1e-20f); am2 = fmaxf(wave_max(am2), 1e-20f);
          const float qa = 127.f / am, qa2 = 127.f / am2;
          unsigned* q8 = (unsigned*)(ws + WS_XN8 + (size_t)m * D_MODEL) + lane; unsigned* q82 = (unsigned*)(ws + WS_XN8 + (size_t)m2 * D_MODEL) + lane;
#pragma unroll
          for (int j = 0; j < 8; ++j) { q8[64 * j] = pk4_i8(v[j][0] * qa, v[j][1] * qa, v[j][2] * qa, v[j][3] * qa); q82[64 * j] = pk4_i8(v2[j][0] * qa2, v2[j][1] * qa2, v2[j][2] * qa2, v2[j][3] * qa2); }
          if (lane == 0) { float* sa = (float*)(ws + WS_SA); sa[m] = am * (1.f / 127.f); sa[m2] = am2 * (1.f / 127.f); } } }

    { const int gt = gw * 64 + lane, NGT = NGW * 64; const int* pos = (const int*)F.in[1]; float* cs = (float*)(ws + WS_COSSIN);
      for (int i = gt; i < T * 8; i += NGT) { const int t = i >> 3, j = i & 7; const float inv = (float)pow(500000.0, -(double)j / 8.0); const float ang = (float)pos[t] * inv;
          cs[t * 16 + j] = (float)cos((double)ang); cs[t * 16 + 8 + j] = (float)sin((double)ang); } }
}
__device__ __forceinline__ void late_weight_copies(Frame& F, int part, int nparts) {
    LAS float* scr = (LAS float*)(F.lds + F.wave * 16384);
    const int gw = part * NWAVES + F.wave, NGW = nparts * NWAVES, lane = F.lane;
    unsigned char* ws = F.ws;
    half_t* WBR_T = (half_t*)(ws + WS_WBR); half_t* WOUT_T = (half_t*)(ws + WS_WOUT);
    constexpr int I_BR = 16 * 64, I_OUT = 32 * 64, NITEMS = 2 * I_BR + I_OUT;
    for (int it = gw; it < NITEMS; it += NGW) {
        int r = it;
        if (r < I_BR) { const int kb = r / 64, nb = r % 64; p0_item<false>(F.in[11], D_MODEL, WBR_T, D_MODEL, 1.f, scr, 64 * kb, 32 * nb, 32 * nb, lane); continue; } r -= I_BR;
        if (r < I_BR) { const int kb = r / 64, nb = r % 64; p0_item<false>(F.in[12], D_MODEL, WBR_T + 1024, D_MODEL, 1.f, scr, 64 * kb, 32 * nb, 32 * nb, lane); continue; } r -= I_BR;
        { const int kb = r / 64, nb = r % 64; p0_item<false>(F.in[13], D_MODEL, WOUT_T, D_MODEL, 1.f, scr, 64 * kb, 32 * nb, 32 * nb, lane); }
    }
    { const int gt = gw * 64 + lane, NGT = NGW * 64; half_t* WRT = (half_t*)(ws + WS_WRT); const float* wg = F.in[15]; const float* we = F.in[17];
      for (int i = gt; i < 80 * D_MODEL; i += NGT) { const int n = i >> 11, k = i & 2047; float v = 0.f; if (n < 8) v = wg[k * 8 + n]; else if (n < 72) v = we[k * 64 + (n - 8)]; WRT[i] = (half_t)v; } }
}

namespace p2 {
constexpr int LDS_K = 0, LDS_V = 49152, LDS_WS = 98304;
constexpr int LDS_W = 0, W_STRIDE = 272, LDS_SC = 128 * W_STRIDE;
constexpr float C2 = 0.125f * 1.4426950408889634f;
__device__ __forceinline__ int crow(int r, int hi) { return (r & 3) + 8 * (r >> 2) + 4 * hi; }
__device__ __forceinline__ s16x4 vtr(const LAS unsigned char* p) { return __builtin_amdgcn_ds_read_tr16_b64_v4i16((LAS s16x4*)p); }
__device__ __forceinline__ h8_t vfrag(const LAS unsigned char* p_lo, const LAS unsigned char* p_hi) {
    const s16x4 lo = vtr(p_lo), hi = vtr(p_hi); typedef short s16x8 __attribute__((ext_vector_type(8)));
    const s16x8 v = {lo[0], lo[1], lo[2], lo[3], hi[0], hi[1], hi[2], hi[3]}; return __builtin_bit_cast(h8_t, v); }

__device__ __forceinline__ void qkt(f32x16& p0, f32x16& p1, const LAS unsigned char* Kt, const h8_t (&qr)[4], int r32, int hi) {
    const LAS unsigned char* kb = Kt + hi * 1024 + r32 * 16;
    p0 = (f32x16){}; p1 = (f32x16){};
#pragma unroll
    for (int d0 = 0; d0 < 4; ++d0) { const h8_t b0 = *(const LAS h8_t*)(kb + d0 * 2048), b1 = *(const LAS h8_t*)(kb + d0 * 2048 + 512);
        p0 = __builtin_amdgcn_mfma_f32_32x32x16_f16(b0, qr[d0], p0, 0, 0, 0); p1 = __builtin_amdgcn_mfma_f32_32x32x16_f16(b1, qr[d0], p1, 0, 0, 0); }
}
__device__ __forceinline__ void mask_tile(f32x16& p0, f32x16& p1, int tile, int ql, int hi, int klo, int khi) {
#pragma unroll
    for (int r = 0; r < 16; ++r) { const int k0 = 64 * tile + crow(r, hi), k1 = k0 + 32;
        const bool v0 = (k0 >= klo) && (k0 < khi) && (k0 - ql >= -WINDOW) && (k0 - ql <= WINDOW);
        const bool v1 = (k1 >= klo) && (k1 < khi) && (k1 - ql >= -WINDOW) && (k1 - ql <= WINDOW);
        p0[r] = v0 ? p0[r] : -1e30f; p1[r] = v1 ? p1[r] : -1e30f; }
}

__device__ __forceinline__ void attn_unit(Frame& F, int b, int qblk, int kvh) {
    const int tid = F.tid, lane = F.lane, wid = F.wave, r32 = lane & 31, hi = lane >> 5;
    const half_t* PROJ = (const half_t*)(F.ws + WS_PROJ); const float* cs = (const float*)(F.ws + WS_COSSIN); half_t* AS = (half_t*)(F.ws + WS_AS);
    const float* qg = F.in[4]; const float* kg = F.in[5]; const float* sink = F.in[6];
    LAS unsigned char* lds = F.lds;
    LAS int* kmx = (LAS int*)(lds + LDS_WS);
    if (tid == 0) *kmx = 0;
    __syncthreads();
    const int kpos0 = 128 * (qblk - 1);
    const int g = wid >> 1, h = kvh * 4 + g;
    h8_t qraw[4]; f32x4 qcs[4];
#define AT_QLOAD(ii) do { const int pb_ = 2 * (wid & 1) + (ii); const size_t tq_ = (size_t)b * SEQ + 128 * qblk + 32 * pb_; const half_t* qp_ = PROJ + (tq_ + r32) * IN_COLS + OFF_Q + h * 64 + hi * 8; \
        _Pragma("unroll") for (int d0 = 0; d0 < 4; ++d0) qraw[d0] = *(const h8_t*)(qp_ + d0 * 16); \
        _Pragma("unroll") for (int q = 0; q < 4; ++q) qcs[q] = *(const f32x4*)(cs + (tq_ + r32) * 16 + 4 * q); } while (0)
    AT_QLOAD(0);
    float k2max = 0.f;
    const int c = tid & 7;
#pragma unroll
    for (int hb = 0; hb < 2; ++hb) {
        h8_t kr[3], vr[3]; f32x4 cc[3][4]; size_t trs[3];
#pragma unroll
        for (int i = 0; i < 3; ++i) { const int row = ((hb * 3 + i) * 512 + tid) >> 3;
            int kp = kpos0 + row; kp = (kp < 0 || kp >= SEQ) ? 0 : kp;
            const size_t trow = (size_t)b * SEQ + kp; trs[i] = trow;
            kr[i] = *(const h8_t*)(PROJ + trow * IN_COLS + OFF_K + kvh * 64 + c * 8);
            vr[i] = *(const h8_t*)(PROJ + trow * IN_COLS + OFF_V + kvh * 64 + c * 8);
#pragma unroll
            for (int q = 0; q < 4; ++q) cc[i][q] = *(const f32x4*)(cs + trow * 16 + 4 * q); }
#pragma unroll
        for (int i = 0; i < 3; ++i) { const int row = ((hb * 3 + i) * 512 + tid) >> 3;
            const h8_t kraw = kr[i], vraw = vr[i];
            float kf[8]; float ss = 0.f;
#pragma unroll
            for (int j = 0; j < 8; ++j) { kf[j] = (float)kraw[j]; ss += kf[j] * kf[j]; }
            ss += __shfl_xor(ss, 1); ss += __shfl_xor(ss, 2); ss += __shfl_xor(ss, 4);
            const float rn = rsqrtf(ss * (1.f / 64.f) + EPS);
            float s2 = 0.f;
#pragma unroll
            for (int j = 0; j < 8; ++j) { kf[j] = (kf[j] * rn) * kg[c * 8 + j]; s2 += kf[j] * kf[j]; }
            s2 += __shfl_xor(s2, 1); s2 += __shfl_xor(s2, 2); s2 += __shfl_xor(s2, 4);
            k2max = fmaxf(k2max, s2);
#pragma unroll
            for (int j = 0; j < 8; ++j) { const float partner = __shfl_xor(kf[j], 1); const float co = cc[i][j >> 2][j & 3], si = cc[i][2 + (j >> 2)][j & 3];
                const float rot = (c == 0) ? (kf[j] * co - partner * si) : (kf[j] * co + partner * si); kf[j] = (c < 2) ? rot : kf[j]; }
            u32x4 kw; kw.x = pkh(kf[0], kf[1]); kw.y = pkh(kf[2], kf[3]); kw.z = pkh(kf[4], kf[5]); kw.w = pkh(kf[6], kf[7]);
            *(LAS u32x4*)(lds + LDS_K + (row >> 6) * 8192 + c * 1024 + (row & 63) * 16) = kw;
            *(LAS h8_t*)(lds + LDS_V + (row >> 6) * 8192 + (c >> 2) * 4096 + ((row & 63) >> 3) * 512 + (row & 7) * 64 + (c & 3) * 16) = vraw; }
    }
    k2max = fmaxf(k2max, __shfl_xor(k2max, 8)); k2max = fmaxf(k2max, __shfl_xor(k2max, 16)); k2max = fmaxf(k2max, __shfl_xor(k2max, 32));
    if (lane == 0) atomicMax((int*)kmx, __float_as_int(k2max));
    __syncthreads();
    const float kmax2 = __int_as_float(*kmx);
    const int klo = (qblk == 0) ? 128 : 0, khi = (qblk == 15) ? 256 : 384;
    const float sk2 = sink[h] * 1.4426950408889634f;
    const int vlane = ((lane >> 4) & 1) * 32 + (lane & 3) * 8 + (4 * hi + ((lane & 15) >> 2)) * 64;
    for (int i = 0; i < 2; ++i) {
        const int pb = 2 * (wid & 1) + i;
        const size_t tq0 = (size_t)b * SEQ + 128 * qblk + 32 * pb;
        const int ql = 128 + 32 * pb + r32;
        h8_t qr[4]; float mB;
        { float qf[4][8]; float ss = 0.f;
#pragma unroll
          for (int d0 = 0; d0 < 4; ++d0) { const h8_t raw = qraw[d0];
#pragma unroll
              for (int j = 0; j < 8; ++j) { qf[d0][j] = (float)raw[j]; ss += qf[d0][j] * qf[d0][j]; } }
          ss += __shfl_xor(ss, 32);
          const float rn = rsqrtf(ss * (1.f / 64.f) + EPS); float q2 = 0.f;
#pragma unroll
          for (int d0 = 0; d0 < 4; ++d0)
#pragma unroll
              for (int j = 0; j < 8; ++j) { qf[d0][j] = (qf[d0][j] * rn) * qg[d0 * 16 + hi * 8 + j]; q2 += qf[d0][j] * qf[d0][j]; }
          q2 += __shfl_xor(q2, 32);
          mB = sqrtf(q2 * kmax2) * C2 - 8.f;
#pragma unroll
          for (int j = 0; j < 8; ++j) { const float partner = __shfl_xor(qf[0][j], 32); const float co = qcs[j >> 2][j & 3], si = qcs[2 + (j >> 2)][j & 3];
              qf[0][j] = (hi == 0) ? (qf[0][j] * co - partner * si) : (qf[0][j] * co + partner * si); }
          __builtin_amdgcn_sched_barrier(0); AT_QLOAD(1); __builtin_amdgcn_sched_barrier(0);
#pragma unroll
          for (int d0 = 0; d0 < 4; ++d0) { u32x4 w; w.x = pkh(qf[d0][0] * C2, qf[d0][1] * C2); w.y = pkh(qf[d0][2] * C2, qf[d0][3] * C2); w.z = pkh(qf[d0][4] * C2, qf[d0][5] * C2); w.w = pkh(qf[d0][6] * C2, qf[d0][7] * C2);
              qr[d0] = __builtin_bit_cast(h8_t, w); } }
        const int t0 = pb >> 1;
        float l = 0.f; f32x16 o[2]; o[0] = (f32x16){}; o[1] = (f32x16){};
#pragma unroll
        for (int tt = 0; tt < 5; ++tt) { const int tile = t0 + tt;
            if (64 * tile < klo || 64 * tile >= khi) continue;
            f32x16 p0, p1;
            qkt(p0, p1, lds + LDS_K + tile * 8192, qr, r32, hi);
            if (tt == 0 || tt == 4) {
#pragma unroll
                for (int r = 0; r < 16; ++r) { const int d0 = 64 * tile + crow(r, hi) - ql, d1 = d0 + 32;
                    p0[r] = (d0 >= -WINDOW && d0 <= WINDOW) ? p0[r] : -1e30f; p1[r] = (d1 >= -WINDOW && d1 <= WINDOW) ? p1[r] : -1e30f; } }
#pragma unroll
            for (int r = 0; r < 16; ++r) { p0[r] = fast_exp2(p0[r] - mB); p1[r] = fast_exp2(p1[r] - mB); l += p0[r] + p1[r]; }
            h8_t pa[4];
            { u32x4 w; w.x = pkh(p0[0], p0[1]); w.y = pkh(p0[2], p0[3]); w.z = pkh(p0[4], p0[5]); w.w = pkh(p0[6], p0[7]); pa[0] = __builtin_bit_cast(h8_t, w);
              w.x = pkh(p0[8], p0[9]); w.y = pkh(p0[10], p0[11]); w.z = pkh(p0[12], p0[13]); w.w = pkh(p0[14], p0[15]); pa[1] = __builtin_bit_cast(h8_t, w);
              w.x = pkh(p1[0], p1[1]); w.y = pkh(p1[2], p1[3]); w.z = pkh(p1[4], p1[5]); w.w = pkh(p1[6], p1[7]); pa[2] = __builtin_bit_cast(h8_t, w);
              w.x = pkh(p1[8], p1[9]); w.y = pkh(p1[10], p1[11]); w.z = pkh(p1[12], p1[13]); w.w = pkh(p1[14], p1[15]); pa[3] = __builtin_bit_cast(h8_t, w); }
            const LAS unsigned char* vb = lds + LDS_V + tile * 8192 + vlane;
#pragma unroll
            for (int dh = 0; dh < 2; ++dh)
#pragma unroll
                for (int ks = 0; ks < 4; ++ks) { const h8_t vf = vfrag(vb + dh * 4096 + ks * 1024, vb + dh * 4096 + ks * 1024 + 512);
                    o[dh] = __builtin_amdgcn_mfma_f32_32x32x16_f16(vf, pa[ks], o[dh], 0, 0, 0); } }
        l += __shfl_xor(l, 32); l += fast_exp2(sk2 - mB);
        const float rl = fast_rcp(l);
        half_t* op = AS + (tq0 + r32) * 2048 + h * 64 + 8 * hi;
#pragma unroll
        for (int dh = 0; dh < 2; ++dh)
#pragma unroll
            for (int gp = 0; gp < 4; gp += 2) { u32x2 wa, wb;
                wa.x = pkh(o[dh][4 * gp] * rl, o[dh][4 * gp + 1] * rl); wa.y = pkh(o[dh][4 * gp + 2] * rl, o[dh][4 * gp + 3] * rl);
                wb.x = pkh(o[dh][4 * gp + 4] * rl, o[dh][4 * gp + 5] * rl); wb.y = pkh(o[dh][4 * gp + 6] * rl, o[dh][4 * gp + 7] * rl);
                const u32x2 r0 = __builtin_amdgcn_permlane32_swap(wa.x, wb.x, false, false), r1 = __builtin_amdgcn_permlane32_swap(wa.y, wb.y, false, false);
                u32x4 o4; o4.x = r0.x; o4.y = r1.x; o4.z = r0.y; o4.w = r1.y;
                *(u32x4*)(op + dh * 32 + gp * 8) = o4; }
    }
#undef AT_QLOAD
    __syncthreads();
}

__device__ __forceinline__ void sg_units(Frame& F) {
    const int tid = F.tid, lane = F.lane, wid = F.wave, r32 = lane & 31, hi = lane >> 5;
    const half_t* PROJ = (const half_t*)(F.ws + WS_PROJ); half_t* AS = (half_t*)(F.ws + WS_AS);
    LAS unsigned char* lds = F.lds;
    const int row = tid >> 2, q4 = tid & 3;
    const int tb = wid >> 1, ch = wid & 1;
    const int t = tb * 32 + r32;
    int u = F.vcu; if (u >= 512) return;
    h8_t sraw[4]; h4_t uraw[2][4];
#define SG_LOAD(uu) do { const size_t row0_ = (size_t)((uu) >> 3) * 128; const int g_ = (uu) & 7; \
        const half_t* sp_ = PROJ + (row0_ + row) * IN_COLS + OFF_S + g_ * 128 + q4 * 32; _Pragma("unroll") for (int j = 0; j < 4; ++j) sraw[j] = *(const h8_t*)(sp_ + j * 8); \
        _Pragma("unroll") for (int nt2 = 0; nt2 < 2; ++nt2) { const half_t* up_ = PROJ + (row0_ + t) * IN_COLS + OFF_U + g_ * 128 + ch * 64 + nt2 * 32 + 4 * hi; \
            _Pragma("unroll") for (int gq = 0; gq < 4; ++gq) uraw[nt2][gq] = *(const h4_t*)(up_ + gq * 8); } } while (0)
    SG_LOAD(u);
    int gprev = -1; f32x4 lg[8], lb[8]; float bt = 0.f;
    for (; u < 512; u += F.G) {
        const int chunk = u >> 3, g = u & 7; const size_t row0 = (size_t)chunk * 128;
        if (g != gprev) {
            const float* W = F.in[9] + (size_t)g * 128 * 128; const f32x4* wp = (const f32x4*)(W + row * 128 + q4 * 32);
            f32x4 wv[8];
#pragma unroll
            for (int j = 0; j < 8; ++j) wv[j] = wp[j];
            const f32x4* gp = (const f32x4*)(F.in[7] + g * 128 + q4 * 32); const f32x4* bp = (const f32x4*)(F.in[8] + g * 128 + q4 * 32);
#pragma unroll
            for (int j = 0; j < 8; ++j) { lg[j] = gp[j]; lb[j] = bp[j]; }
            bt = (F.in[10] + g * 128)[t];
#pragma unroll
            for (int j = 0; j < 4; ++j) { const f32x4 a = wv[2 * j], c = wv[2 * j + 1]; u32x4 w; w.x = pkh(a[0], a[1]); w.y = pkh(a[2], a[3]); w.z = pkh(c[0], c[1]); w.w = pkh(c[2], c[3]);
                *(LAS u32x4*)(lds + LDS_W + row * W_STRIDE + q4 * 64 + j * 16) = w; }
            gprev = g; }
        { float xv[32]; float s = 0.f;
#pragma unroll
          for (int j = 0; j < 4; ++j)
#pragma unroll
              for (int e = 0; e < 8; ++e) { xv[j * 8 + e] = (float)sraw[j][e]; s += xv[j * 8 + e]; }
          s += __shfl_xor(s, 1); s += __shfl_xor(s, 2); const float mean = s * (1.f / 128.f); float qq = 0.f;
#pragma unroll
          for (int e = 0; e < 32; ++e) { xv[e] -= mean; qq += xv[e] * xv[e]; }
          qq += __shfl_xor(qq, 1); qq += __shfl_xor(qq, 2); const float rstd = rsqrtf(qq * (1.f / 128.f) + EPS);
#pragma unroll
          for (int j = 0; j < 4; ++j) { float y[8];
#pragma unroll
              for (int e = 0; e < 8; ++e) y[e] = (xv[j * 8 + e] * rstd) * lg[2 * j + (e >> 2)][e & 3] + lb[2 * j + (e >> 2)][e & 3];
              u32x4 w; w.x = pkh(y[0], y[1]); w.y = pkh(y[2], y[3]); w.z = pkh(y[4], y[5]); w.w = pkh(y[6], y[7]);
              *(LAS u32x4*)(lds + LDS_SC + ((row >> 3) * 4 + q4) * 512 + (row & 7) * 64 + j * 16) = w; } }
        h4_t uvv[2][4];
#pragma unroll
        for (int nt2 = 0; nt2 < 2; ++nt2)
#pragma unroll
            for (int gq = 0; gq < 4; ++gq) uvv[nt2][gq] = uraw[nt2][gq];
        __builtin_amdgcn_sched_barrier(0);
        { const int un = (u + F.G < 512) ? u + F.G : u; SG_LOAD(un); }
        __builtin_amdgcn_sched_barrier(0);
        __syncthreads();
        f32x16 acc[2]; acc[0] = (f32x16){}; acc[1] = (f32x16){};
        const LAS unsigned char* wp2 = lds + LDS_W + (tb * 32 + r32) * W_STRIDE + hi * 16;
        const int blane = hi * 2048 + ((lane & 15) >> 2) * 64 + ((lane >> 4) & 1) * 32 + (lane & 3) * 8;
#pragma unroll
        for (int ks = 0; ks < 8; ++ks) { const h8_t wf = *(const LAS h8_t*)(wp2 + ks * 32);
#pragma unroll
            for (int nt2 = 0; nt2 < 2; ++nt2) { const LAS unsigned char* bp2 = lds + LDS_SC + (ks * 8 + (ch * 2 + nt2)) * 512 + blane;
                const h8_t sf = vfrag(bp2, bp2 + 256); acc[nt2] = __builtin_amdgcn_mfma_f32_32x32x16_f16(sf, wf, acc[nt2], 0, 0, 0); } }
#pragma unroll
        for (int nt2 = 0; nt2 < 2; ++nt2) { const int c0 = ch * 64 + nt2 * 32 + 8 * hi; half_t* op = AS + (row0 + t) * 2048 + 1024 + g * 128 + c0;
#pragma unroll
            for (int gp = 0; gp < 4; gp += 2) { u32x2 wv[2];
#pragma unroll
                for (int q = 0; q < 2; ++q) { const int gq = gp + q; const h4_t uv = uvv[nt2][gq];
                    wv[q].x = pkh((float)uv[0] * (acc[nt2][4 * gq] + bt), (float)uv[1] * (acc[nt2][4 * gq + 1] + bt)); wv[q].y = pkh((float)uv[2] * (acc[nt2][4 * gq + 2] + bt), (float)uv[3] * (acc[nt2][4 * gq + 3] + bt)); }
                const u32x2 r0 = __builtin_amdgcn_permlane32_swap(wv[0].x, wv[1].x, false, false), r1 = __builtin_amdgcn_permlane32_swap(wv[0].y, wv[1].y, false, false);
                u32x4 o4; o4.x = r0.x; o4.y = r1.x; o4.z = r0.y; o4.w = r1.y;
                *(u32x4*)(op + gp * 8) = o4; } }
        __syncthreads();
    }
#undef SG_LOAD
}
__device__ __forceinline__ void phase(Frame& F) {
    for (int u = F.vcu; u < 256; u += F.G) attn_unit(F, u >> 6, (u >> 2) & 15, u & 3);
    sg_units(F);
}
}

namespace mg {
#ifndef TEST_MT
#define TEST_MT 384
#endif
constexpr int MT = 384, BUFB = 16384, UMT = TEST_MT;
struct Unit { int e, m0, nrows, ns, rowbase; };
__device__ __forceinline__ void build_tables(Frame& F, const unsigned* cnt) {
    if (F.tid < 64) { const int e = F.tid; const unsigned c = cnt[e * 64]; const unsigned ntl = (c + (unsigned)UMT - 1u) / (unsigned)UMT;
        unsigned off = c, tp = ntl;
#pragma unroll
        for (int o = 1; o < 64; o <<= 1) { const unsigned a = __shfl_up(off, o), b2 = __shfl_up(tp, o); if (e >= o) { off += a; tp += b2; } }
        F.MISC[MI_CNT + e] = c; F.MISC[MI_OFFS + e] = off - c;
        for (unsigned j = 0; j < ntl; ++j) F.MISC[MI_MT + (tp - ntl) + j] = (unsigned)e | (j << 8);
        if (e == 63) F.MISC[MI_NT] = tp; }
    __syncthreads();
}
__device__ __forceinline__ bool get_unit(const volatile LAS unsigned* MISC, int idx, int ns_shift, Unit& u) {
    const int NT = (int)MISC[MI_NT]; const int mt = idx >> ns_shift; if (mt >= NT) return false;
    const unsigned ent = MISC[MI_MT + mt]; u.e = __builtin_amdgcn_readfirstlane((int)(ent & 0xffu)); const int j = __builtin_amdgcn_readfirstlane((int)(ent >> 8));
    u.ns = idx & ((1 << ns_shift) - 1); u.m0 = j * UMT;
    const int c = __builtin_amdgcn_readfirstlane((int)MISC[MI_CNT + u.e]); u.nrows = min(UMT, c - u.m0);
    u.rowbase = __builtin_amdgcn_readfirstlane((int)MISC[MI_OFFS + u.e]) + u.m0; return true;
}
typedef f32x4 Acc[3][8];
struct EpiPre { int a[3]; float f[3]; };
constexpr int LDS_BIMG = 0, LDS_ABUF = 3 * BUFB, ABUFB = MT * 128;
template <class P>
__device__ __forceinline__ void phase(LAS unsigned char* lds, const P& S) {
    const int tid = threadIdx.x, wid = __builtin_amdgcn_readfirstlane(tid >> 6), lane = tid & 63, fr = lane & 15, fq = lane >> 4;
    const int nt = S.nt, ldb = S.ldb;
    const int bk0 = tid >> 5, bn0 = (tid & 31) * 4;
    const int gofs0 = bk0 * ldb + (bn0 & 63);
    const int bch = (bn0 & 31) >> 2, bsl = (bch & 1) * 4 + (bch >> 1), bns = (bn0 & ~31) + bsl * 4;
    const int wofs0 = LDS_BIMG + ((bk0 >> 3) * 4 + (bns >> 5)) * 512 + (bk0 & 7) * 64 + ((((bns >> 4) & 1) ^ ((bk0 >> 3) & 1)) * 32) + (bns & 15) * 2;
    const bool seg1 = bn0 >= 64;
    const int achunk = tid & 7, arow0 = tid >> 3;
    const int awofs0 = LDS_ABUF + arow0 * 128 + ((achunk ^ (arow0 & 7)) * 16);
    const int q4 = (lane & 15) >> 2, p4 = lane & 3;
    const int lb0 = LDS_BIMG + fq * 2048 + q4 * 64 + p4 * 8 + ((fq & 1) * 32), lb1 = lb0 ^ 32;
    const int afo0 = LDS_ABUF + (wid * 16 + fr) * 128 + ((fq ^ (fr & 7)) * 16), afo1 = LDS_ABUF + (wid * 16 + fr) * 128 + (((4 + fq) ^ (fr & 7)) * 16);
    Unit u, un; int ui = 0;
    if (!S.next(0, u)) return;
    const half_t* abase = S.abase();
    const float* bp; int aofs[6]; bool v3 = true, v3n = true;
    f32x4 St[2][4]; u32x4 As[6];
#define MG_KT(kt) (kt)
#define MG_SETUP(uu) do { bp = seg1 ? S.b1(uu) : S.b0(uu); v3n = (wid + 16) * 16 < (uu).nrows; \
        _Pragma("unroll") for (int i_ = 0; i_ < 6; ++i_) { const int row_ = 64 * i_ + arow0; aofs[i_] = S.aoff(uu, min(row_, (uu).nrows - 1)) + achunk * 8; } } while (0)
#define MG_LOADB(s, kt) do { const int kt_ = (kt); const bool ok_ = kt_ < nt;                  \
        _Pragma("unroll") for (int i_ = 0; i_ < 4; ++i_) St[s][i_] = __builtin_nontemporal_load((const f32x4*)(bp + (ok_ ? (size_t)(MG_KT(kt_) * 64 + 16 * i_) * ldb + gofs0 : (size_t)0))); } while (0)
#define MG_LOADA(kt) do { const int kt_ = (kt); const bool ok_ = kt_ < nt; \
        _Pragma("unroll") for (int i_ = 0; i_ < 6; ++i_) As[i_] = *(const u32x4*)(abase + (ok_ ? aofs[i_] + MG_KT(kt_) * 64 : 0)); } while (0)
#define MG_WRITEB(s, bo) do { _Pragma("unroll") for (int i_ = 0; i_ < 4; ++i_) { u32x2 w_; w_.x = pkh(St[s][i_][0], St[s][i_][1]); w_.y = pkh(St[s][i_][2], St[s][i_][3]); *(LAS u32x2*)(lds + (bo) + wofs0 + 4096 * i_) = w_; } } while (0)
#define MG_WRITEA(ao) do { _Pragma("unroll") for (int i_ = 0; i_ < 6; ++i_) *(LAS u32x4*)(lds + (ao) + awofs0 + 8192 * i_) = As[i_]; } while (0)
#define MG_WRITEA_P(i0, i1, ao) do { _Pragma("unroll") for (int i_ = (i0); i_ < (i1); ++i_) *(LAS u32x4*)(lds + (ao) + awofs0 + 8192 * i_) = As[i_]; } while (0)
#define MG_AF(ks_, ao) do { _Pragma("unroll") for (int j_ = 0; j_ < 3; ++j_) af_[j_] = *(const LAS h8_t*)(lds + (ao) + ((ks_) ? afo1 : afo0) + j_ * 8 * 16 * 128); } while (0)
#define MG_GROUP(V2, ks_, hf_, bo) do { h8_t bf_[4]; \
            _Pragma("unroll") for (int n4_ = 0; n4_ < 4; ++n4_) { const int nf_ = (hf_) * 4 + n4_; const LAS unsigned char* p_ = lds + (bo) + ((nf_ & 1) ? lb1 : lb0) + (ks_) * 8192 + (nf_ >> 1) * 512; bf_[n4_] = p2::vfrag(p_, p_ + 256); } \
            _Pragma("unroll") for (int j_ = 0; j_ < 2; ++j_) { _Pragma("unroll") for (int n4_ = 0; n4_ < 4; ++n4_) acc[j_][(hf_) * 4 + n4_] = __builtin_amdgcn_mfma_f32_16x16x32_f16(bf_[n4_], af_[j_], acc[j_][(hf_) * 4 + n4_], 0, 0, 0); } \
            if (v3) { _Pragma("unroll") for (int n4_ = 0; n4_ < 4; ++n4_) acc[2][(hf_) * 4 + n4_] = __builtin_amdgcn_mfma_f32_16x16x32_f16(bf_[n4_], af_[2], acc[2][(hf_) * 4 + n4_], 0, 0, 0); } } while (0)
#define MG_SB __builtin_amdgcn_sched_barrier(0)
#define MG_BODY(V2, tt, s) do { const int bn_ = (bcur == 2 * BUFB) ? 0 : bcur + BUFB; const int an_ = acur ^ ABUFB; h8_t af_[3]; \
            MG_AF(0, acur); MG_GROUP(V2, 0, 0, bcur); MG_SB; \
            MG_WRITEA_P(0, 3, an_); MG_SB; \
            MG_GROUP(V2, 0, 1, bcur); MG_SB; \
            MG_WRITEA_P(3, 6, an_); MG_LOADA((tt) + 2); MG_SB; \
            MG_AF(1, acur); MG_GROUP(V2, 1, 0, bcur); MG_SB; \
            MG_WRITEB((s) ^ 1, bn_); MG_LOADB((s) ^ 1, (tt) + 3); MG_SB; \
            MG_GROUP(V2, 1, 1, bcur); \
            __syncthreads(); bcur = bn_; acur = an_; } while (0)
    MG_SETUP(u);
    MG_LOADA(0); __builtin_amdgcn_sched_barrier(0); MG_LOADB(0, 0); MG_LOADB(1, 1);
    for (;;) {
        Acc acc;
#pragma unroll
        for (int j = 0; j < 3; ++j)
#pragma unroll
            for (int nf = 0; nf < 8; ++nf) acc[j][nf] = (f32x4){0.f, 0.f, 0.f, 0.f};
        v3 = v3n;
        MG_WRITEB(0, 0); MG_WRITEA(0); MG_LOADA(1); __builtin_amdgcn_sched_barrier(0); MG_LOADB(0, 2);
        __syncthreads();
        int bcur = 0, acur = 0;
#pragma unroll 1
            for (int t = 0; t < nt; t += 2) { MG_BODY(true, t, 0); MG_BODY(true, t + 1, 1); }
        const bool has_next = S.next(ui + 1, un);
        EpiPre pre; S.epi_pre(u, wid, fr, pre);
        if (has_next) MG_SETUP(un);
        asm volatile("" : "+v"(pre.a[0]), "+v"(pre.a[1]), "+v"(pre.a[2]), "+v"(pre.f[0]), "+v"(pre.f[1]), "+v"(pre.f[2]));
        if (has_next) { MG_LOADA(0); __builtin_amdgcn_sched_barrier(0); MG_LOADB(0, 0); MG_LOADB(1, 1); }
        __builtin_amdgcn_sched_barrier(0);
        S.epi(acc, u, wid, fr, fq, pre);
        if (!has_next) break;
        u = un; ++ui;
    }
#undef MG_KT
#undef MG_SETUP
#undef MG_LOADB
#undef MG_LOADA
#undef MG_WRITEB
#undef MG_WRITEA
#undef MG_WRITEA_P
#undef MG_AF
#undef MG_GROUP
#undef MG_SB
#undef MG_BODY
}
}
struct GUProb {
    int nt, ldb; const volatile LAS unsigned* MISC; int vcu, G; const half_t* H16; const float* Wg; const float* Wu; const int* LIST; const float* RSE; half_t* HID;
    __device__ __forceinline__ bool next(int i, mg::Unit& u) const { return mg::get_unit(MISC, vcu + i * G, 3, u); }
    __device__ __forceinline__ const float* b0(const mg::Unit& u) const { return Wg + ((size_t)u.e * D_MODEL * EXPERT_FF + u.ns * 64); }
    __device__ __forceinline__ const float* b1(const mg::Unit& u) const { return Wu + ((size_t)u.e * D_MODEL * EXPERT_FF + u.ns * 64); }
    __device__ __forceinline__ const half_t* abase() const { return H16; }
    __device__ __forceinline__ int aoff(const mg::Unit& u, int m) const { const int tok = LIST[u.e * 8192 + u.m0 + m] >> 1; return tok * D_MODEL; }
    __device__ __forceinline__ void epi_pre(const mg::Unit& u, int wid, int fr, mg::EpiPre& p) const {
#pragma unroll
        for (int j = 0; j < 3; ++j) { const int m = min((wid + 8 * j) * 16 + fr, u.nrows - 1); p.a[j] = 0; p.f[j] = RSE[u.e * 8192 + u.m0 + m]; }
    }
    __device__ __forceinline__ void epi(mg::Acc& acc, const mg::Unit& u, int wid, int fr, int fq, const mg::EpiPre& p) const {
#pragma unroll
        for (int j = 0; j < 3; ++j) { const int m = (wid + 8 * j) * 16 + fr;
            if (m < u.nrows) { const float r = p.f[j]; half_t* hp = HID + (size_t)(u.rowbase + m) * EXPERT_FF + u.ns * 64 + 8 * fq;
#pragma unroll
                for (int g = 0; g < 2; ++g) { u32x4 w;
#pragma unroll
                    for (int n = 0; n < 2; ++n) { f32x4 gt = acc[j][2 * g + n] * r; const f32x4 uu = acc[j][2 * g + n + 4] * r;
#pragma unroll
                        for (int e = 0; e < 4; ++e) gt[e] = gt[e] * sigm_f(gt[e]) * uu[e];
                        if (n == 0) { w.x = pkh(gt[0], gt[1]); w.y = pkh(gt[2], gt[3]); } else { w.z = pkh(gt[0], gt[1]); w.w = pkh(gt[2], gt[3]); } }
                    *(u32x4*)(hp + g * 32) = w; } } }
    }
};
struct DownProb {
    int nt, ldb; const volatile LAS unsigned* MISC; int vcu, G; const half_t* HID; const float* Wd; const int* LIST; const float* RWE; unsigned char* Y2;
    __device__ __forceinline__ bool next(int i, mg::Unit& u) const { return mg::get_unit(MISC, vcu + i * G, 4, u); }
    __device__ __forceinline__ const float* b0(const mg::Unit& u) const { return Wd + (size_t)u.e * EXPERT_FF * D_MODEL + u.ns * 128; }
    __device__ __forceinline__ const float* b1(const mg::Unit& u) const { return Wd + (size_t)u.e * EXPERT_FF * D_MODEL + u.ns * 128 + 64; }
    __device__ __forceinline__ const half_t* abase() const { return HID; }
    __device__ __forceinline__ int aoff(const mg::Unit& u, int m) const { return (u.rowbase + m) * EXPERT_FF; }
    __device__ __forceinline__ void epi_pre(const mg::Unit& u, int wid, int fr, mg::EpiPre& p) const {
#pragma unroll
        for (int j = 0; j < 3; ++j) { const int m = min((wid + 8 * j) * 16 + fr, u.nrows - 1); p.a[j] = LIST[u.e * 8192 + u.m0 + m]; p.f[j] = RWE[u.e * 8192 + u.m0 + m]; }
    }
    __device__ __forceinline__ void epi(mg::Acc& acc, const mg::Unit& u, int wid, int fr, int fq, const mg::EpiPre& p) const {
        const bool odd = (fq & 1) != 0;
#pragma unroll
        for (int j = 0; j < 3; ++j) { const int m = (wid + 8 * j) * 16 + fr; const float w8 = p.f[j];
            unsigned char* yp = Y2 + (size_t)p.a[j] * D_MODEL + u.ns * 128 + (odd ? 8 * (fq - 1) + 32 : 8 * fq);
#pragma unroll
            for (int gp = 0; gp < 4; gp += 2) { u32x2 wa, wb;
                { const f32x4 v0 = acc[j][2 * gp] * w8, v1 = acc[j][2 * gp + 1] * w8; wa.x = pk4_fp8(v0[0], v0[1], v0[2], v0[3]); wa.y = pk4_fp8(v1[0], v1[1], v1[2], v1[3]); }
                { const f32x4 v0 = acc[j][2 * gp + 2] * w8, v1 = acc[j][2 * gp + 3] * w8; wb.x = pk4_fp8(v0[0], v0[1], v0[2], v0[3]); wb.y = pk4_fp8(v1[0], v1[1], v1[2], v1[3]); }
                const u32x2 r0 = __builtin_amdgcn_permlane16_swap(wa.x, wb.x, false, false), r1 = __builtin_amdgcn_permlane16_swap(wa.y, wb.y, false, false);
                u32x4 o4; o4.x = r0.x; o4.y = r1.x; o4.z = r0.y; o4.w = r1.y;
                if (m < u.nrows) *(u32x4*)(yp + gp * 32) = o4; } }
    }
};

__device__ __forceinline__ void p5_router(Frame& F) {
    const int tid = F.tid, lane = F.lane, wid = F.wave, fr = lane & 15, fq = lane >> 4;
    const half_t* H16 = (const half_t*)(F.ws + WS_H16); const half_t* WRT = (const half_t*)(F.ws + WS_WRT); const float* ROWSS = (const float*)(F.ws + WS_ROWSS);
    float* RSTD2 = (float*)(F.ws + WS_RSTD2); float* RW = (float*)(F.ws + WS_ROUTEW); int* LIST = (int*)(F.ws + WS_LIST); unsigned* cnt = F.ctl + CW_CNT2;
    float* RSE = (float*)(F.ws + WS_RSE); float* RWE = (float*)(F.ws + WS_RWE);
    const float* bg = F.in[16]; const float* be = F.in[18];
    LAS float* LG = (LAS float*)F.lds;
    LAS float* RS = (LAS float*)(F.lds + 8 * 32 * 80 * 4);
    for (int blk = F.vcu; blk < T / 32; blk += F.G) {
        const int row0 = blk * 32;
        { const int row = tid >> 4, j = tid & 15; const float* rp = ROWSS + (size_t)(row0 + row) * 32 + 2 * j; float ss = rp[0] + rp[1];
          ss += __shfl_xor(ss, 1); ss += __shfl_xor(ss, 2); ss += __shfl_xor(ss, 4); ss += __shfl_xor(ss, 8);
          if (j == 0) RS[row] = rsqrtf(ss * (1.f / D_MODEL) + EPS); }
        f32x4 acc[2][5];
#pragma unroll
        for (int m = 0; m < 2; ++m)
#pragma unroll
            for (int nf = 0; nf < 5; ++nf) acc[m][nf] = (f32x4){0.f, 0.f, 0.f, 0.f};
        const half_t* ap = H16 + (size_t)(row0 + fr) * D_MODEL + wid * 256 + fq * 8;
        const half_t* bp = WRT + (size_t)fr * D_MODEL + wid * 256 + fq * 8;
#pragma unroll
        for (int half = 0; half < 2; ++half) { h8_t af[4][2], bf[4][5];
#pragma unroll
            for (int k4 = 0; k4 < 4; ++k4) { const int kk = half * 4 + k4;
#pragma unroll
                for (int m = 0; m < 2; ++m) af[k4][m] = *(const h8_t*)(ap + (size_t)m * 16 * D_MODEL + kk * 32);
#pragma unroll
                for (int nf = 0; nf < 5; ++nf) bf[k4][nf] = *(const h8_t*)(bp + (size_t)nf * 16 * D_MODEL + kk * 32); }
#pragma unroll
            for (int k4 = 0; k4 < 4; ++k4)
#pragma unroll
                for (int m = 0; m < 2; ++m)
#pragma unroll
                    for (int nf = 0; nf < 5; ++nf) acc[m][nf] = __builtin_amdgcn_mfma_f32_16x16x32_f16(af[k4][m], bf[k4][nf], acc[m][nf], 0, 0, 0); }
#pragma unroll
        for (int m = 0; m < 2; ++m)
#pragma unroll
            for (int nf = 0; nf < 5; ++nf)
#pragma unroll
                for (int r = 0; r < 4; ++r) LG[(wid * 32 + m * 16 + fq * 4 + r) * 80 + nf * 16 + fr] = acc[m][nf][r];
        __syncthreads();
        for (int o = tid; o < 32 * 80; o += 512) LG[o] = ((LG[o] + LG[2560 + o]) + (LG[5120 + o] + LG[7680 + o])) + ((LG[10240 + o] + LG[12800 + o]) + (LG[15360 + o] + LG[17920 + o]));
        __syncthreads();
        if (tid < 32) { const int t = row0 + tid; const float r = RS[tid]; RSTD2[t] = r;
            const LAS float* lg = LG + tid * 80;
            int grp = 0; float mx = lg[0] * r + bg[0]; float gl[8]; gl[0] = mx;
#pragma unroll
            for (int j = 1; j < 8; ++j) { gl[j] = lg[j] * r + bg[j]; if (gl[j] > mx) { mx = gl[j]; grp = j; } }
            float den = 0.f;
#pragma unroll
            for (int j = 0; j < 8; ++j) den += __expf(gl[j] - mx);
            const float gw = 1.f / den;
            float el[8];
#pragma unroll
            for (int j = 0; j < 8; ++j) el[j] = lg[8 + grp * 8 + j] * r + be[grp * 8 + j];
            int i0 = 0; float v0 = el[0];
#pragma unroll
            for (int j = 1; j < 8; ++j) if (el[j] > v0) { v0 = el[j]; i0 = j; }
            int i1 = 0; float v1 = -INFINITY;
#pragma unroll
            for (int j = 0; j < 8; ++j) if (j != i0 && el[j] > v1) { v1 = el[j]; i1 = j; }
            const float e1 = __expf(v1 - v0); const float w0 = gw / (1.f + e1), w1 = gw * e1 / (1.f + e1);
            const int ex0 = grp * 8 + i0, ex1 = grp * 8 + i1;
            const unsigned p0 = atomicAdd(&cnt[ex0 * 64], 1u); const unsigned p1 = atomicAdd(&cnt[ex1 * 64], 1u);
            LIST[ex0 * 8192 + p0] = t * 2; RW[t * 2] = w0; LIST[ex1 * 8192 + p1] = t * 2 + 1; RW[t * 2 + 1] = w1;
            RSE[ex0 * 8192 + p0] = r; RSE[ex1 * 8192 + p1] = r; RWE[ex0 * 8192 + p0] = w0; RWE[ex1 * 8192 + p1] = w1; }
        __syncthreads();
    }
}
__device__ __forceinline__ void p8_combine(Frame& F) {
    const unsigned char* Y2 = F.ws + WS_Y2; const half_t* H16 = (const half_t*)(F.ws + WS_H16); const float* g2 = F.in[14]; float* out = F.out;
    const size_t gt = (size_t)(F.vcu * NWAVES + F.wave) * 64 + F.lane, NGT = (size_t)F.G * 512, NI = (size_t)T * D_MODEL / 8;
#define P8_LOAD(A_, B_, H_, GA_, GB_, i_) do { const size_t t_ = (i_) >> 8, c8_ = ((i_) & 255) * 8; A_ = *(const u32x2*)(Y2 + (t_ * 2) * D_MODEL + c8_); B_ = *(const u32x2*)(Y2 + (t_ * 2 + 1) * D_MODEL + c8_); \
        H_ = *(const h8_t*)(H16 + t_ * D_MODEL + c8_); GA_ = *(const f32x4*)(g2 + c8_); GB_ = *(const f32x4*)(g2 + c8_ + 4); } while (0)
    u32x2 a, b, an, bn; h8_t hh, hn; f32x4 ga, gb, gan, gbn;
    size_t i = gt;
    if (i < NI) P8_LOAD(a, b, hh, ga, gb, i);
    for (; i < NI; i += NGT) {
        const size_t inx = i + NGT;
        if (inx < NI) P8_LOAD(an, bn, hn, gan, gbn, inx);
        asm volatile("" ::: "memory");
        const size_t t = i >> 8, c8 = (i & 255) * 8;
        const f32x2 a0 = __builtin_amdgcn_cvt_pk_f32_fp8((int)a.x, false), a1 = __builtin_amdgcn_cvt_pk_f32_fp8((int)a.x, true), a2 = __builtin_amdgcn_cvt_pk_f32_fp8((int)a.y, false), a3 = __builtin_amdgcn_cvt_pk_f32_fp8((int)a.y, true);
        const f32x2 b0 = __builtin_amdgcn_cvt_pk_f32_fp8((int)b.x, false), b1 = __builtin_amdgcn_cvt_pk_f32_fp8((int)b.x, true), b2 = __builtin_amdgcn_cvt_pk_f32_fp8((int)b.y, false), b3 = __builtin_amdgcn_cvt_pk_f32_fp8((int)b.y, true);
        f32x4 o0, o1;
        o0[0] = (float)hh[0] * fast_rcp(ga[0]) + (a0[0] + b0[0]); o0[1] = (float)hh[1] * fast_rcp(ga[1]) + (a0[1] + b0[1]);
        o0[2] = (float)hh[2] * fast_rcp(ga[2]) + (a1[0] + b1[0]); o0[3] = (float)hh[3] * fast_rcp(ga[3]) + (a1[1] + b1[1]);
        o1[0] = (float)hh[4] * fast_rcp(gb[0]) + (a2[0] + b2[0]); o1[1] = (float)hh[5] * fast_rcp(gb[1]) + (a2[1] + b2[1]);
        o1[2] = (float)hh[6] * fast_rcp(gb[2]) + (a3[0] + b3[0]); o1[3] = (float)hh[7] * fast_rcp(gb[3]) + (a3[1] + b3[1]);
        f32x4* dp = (f32x4*)(out + t * D_MODEL + c8); dp[0] = o0; dp[1] = o1;
        asm volatile("" ::: "memory");
        a = an; b = bn; hh = hn; ga = gan; gb = gbn;
    }
#undef P8_LOAD
}
constexpr int N_PHASES = 9;
struct Args { const float* in[22]; float* out; unsigned char* ws; int ph_lo, ph_hi, use_bar, pad; };
__global__ void __launch_bounds__(NWAVES * 64, 2) mk_fwd(Args args) {
    extern __shared__ __attribute__((aligned(16))) unsigned char lds_raw[];
    Frame F;
    F.lds = (LAS unsigned char*)lds_raw; F.MISC = (volatile LAS unsigned*)(F.lds + MISC_OFF);
    F.tid = threadIdx.x; F.lane = F.tid & 63; F.wave = __builtin_amdgcn_readfirstlane(F.tid >> 6);
    F.G = gridDim.x; { const int bx = blockIdx.x; F.vcu = (F.G % 8 == 0) ? (bx % 8) * (F.G / 8) + bx / 8 : bx; }
#pragma unroll
    for (int i = 0; i < 22; ++i) F.in[i] = args.in[i];
    F.out = args.out; F.ws = args.ws; F.ctl = (unsigned*)(args.ws + WS_CTL);
    for (int u = F.tid; u < (LDS_BYTES - MISC_OFF) / 4; u += NWAVES * 64) ((LAS unsigned*)(F.lds + MISC_OFF))[u] = 0u;
    __syncthreads();
    XcdBarrier bar; bar.bar = F.ctl + CW_BAR; bar.x = 0; bar.st = nullptr;
    if (args.use_bar) bar = xcd_barrier_post(F.ctl + CW_BAR, F.MISC + MI_BAR);
    const int lo = args.ph_lo, hi = args.ph_hi;
#define IN(k) (lo <= (k) && (k) < hi)
#define SEAM(k) do { if (IN(k) && IN((k) + 1)) xcd_barrier(bar); } while (0)
    unsigned char* ws = args.ws;
    if (IN(0)) { p0_prologue(F); } SEAM(0);
    if (IN(1)) {
        { ProjProbI8 P; P.nt = 16; P.ldb = D_MODEL / 2; P.ord.init(T, 30 * 256, F.G, (int)blockIdx.x); P.A = ws + WS_XN8; P.Bt = ws + WS_W8; P.O = (half_t*)(ws + WS_PROJ);
          P.SA = (const float*)(ws + WS_SA); P.sW = *(const float*)(ws + WS_SW);
          pg::gemm_phase<ProjProbI8, true>(F.lds, P); }
        { const int nwg = (T / 256) * 30, full = nwg % F.G;
          const int first = full ? full : 0, nparts = F.G - first;
          if ((int)blockIdx.x >= first) { __syncthreads(); late_weight_copies(F, (int)blockIdx.x - first, nparts); } } } SEAM(1);
    if (IN(2)) { p2::phase(F); } SEAM(2);
    if (IN(3)) { MergeProb P; P.nt = 32; P.ldb = D_MODEL; P.ord.init(T, D_MODEL, F.G, (int)blockIdx.x); P.A = (const half_t*)(ws + WS_AS); P.Bt = (const half_t*)(ws + WS_WBR); P.PROJ = (const half_t*)(ws + WS_PROJ); P.O = (half_t*)(ws + WS_MERGED);
        pg::gemm_phase<MergeProb, true>(F.lds, P); } SEAM(3);
    if (IN(4)) { OutProb P; P.nt = 32; P.ldb = D_MODEL; P.ord.init(T, D_MODEL, F.G, (int)blockIdx.x); P.A = (const half_t*)(ws + WS_MERGED); P.Bt = (const half_t*)(ws + WS_WOUT); P.x = F.in[0]; P.g2 = F.in[14]; P.out = F.out;
        P.H16 = (half_t*)(ws + WS_H16); P.ROWSS = (float*)(ws + WS_ROWSS);
        pg::gemm_phase<OutProb, true>(F.lds, P); } SEAM(4);
    if (IN(5)) { p5_router(F); } SEAM(5);
    if (IN(6)) { mg::build_tables(F, F.ctl + CW_CNT2);
        GUProb P; P.nt = 32; P.ldb = EXPERT_FF; P.MISC = F.MISC; P.vcu = F.vcu; P.G = F.G; P.H16 = (const half_t*)(ws + WS_H16); P.Wg = F.in[19]; P.Wu = F.in[20]; P.LIST = (const int*)(ws + WS_LIST);
        P.RSE = (const float*)(ws + WS_RSE); P.HID = (half_t*)(ws + WS_HID);
        mg::phase<GUProb>(F.lds, P); } SEAM(6);
    if (IN(7)) { mg::build_tables(F, F.ctl + CW_CNT2);
        DownProb P; P.nt = 8; P.ldb = D_MODEL; P.MISC = F.MISC; P.vcu = F.vcu; P.G = F.G; P.HID = (const half_t*)(ws + WS_HID); P.Wd = F.in[21]; P.LIST = (const int*)(ws + WS_LIST);
        P.RWE = (const float*)(ws + WS_RWE); P.Y2 = ws + WS_Y2;
        mg::phase<DownProb>(F.lds, P); } SEAM(7);
    if (IN(8)) { p8_combine(F); }
#undef IN
#undef SEAM
}

extern "C" void kernel_launch(void* const* d_in, const int* in_sizes, int n_in, void* d_out, int out_size, void* d_ws, size_t ws_size, hipStream_t stream) {
    if (n_in != 22 || out_size != T * D_MODEL || ws_size < WS_END) { fprintf(stderr, "kernel_launch: unexpected shapes (n_in %d out %d ws %zu)\n", n_in, out_size, ws_size); return; }
    static int grid = 0;
    if (grid == 0) {
        int dev = 0, cus = 0;
        if (hipGetDevice(&dev) != hipSuccess || hipDeviceGetAttribute(&cus, hipDeviceAttributeMultiprocessorCount, dev) != hipSuccess) { fprintf(stderr, "kernel_launch: device query failed\n"); grid = -1; return; }
        if (hipFuncSetAttribute((const void*)mk_fwd, hipFuncAttributeMaxDynamicSharedMemorySize, LDS_BYTES) != hipSuccess) { fprintf(stderr, "kernel_launch: hipFuncSetAttribute failed\n"); grid = -1; return; }
        int per_cu = 0; (void)hipOccupancyMaxActiveBlocksPerMultiprocessor(&per_cu, (const void*)mk_fwd, NWAVES * 64, LDS_BYTES); (void)hipGetLastError();
        if (per_cu < 1) fprintf(stderr, "kernel_launch: occupancy query says %d blocks/CU\n", per_cu);
        grid = cus;
    }
    if (grid < 0) return;
    (void)hipMemsetAsync((unsigned char*)d_ws + WS_CTL, 0, CTL_ZERO_BYTES, stream);
    Args a{};
    for (int i = 0; i < 22; ++i) a.in[i] = (const float*)d_in[i];
    a.out = (float*)d_out; a.ws = (unsigned char*)d_ws; a.ph_lo = 0; a.ph_hi = N_PHASES; a.use_bar = 1;
    hipLaunchKernelGGL(mk_fwd, dim3(grid), dim3(NWAVES * 64), LDS_BYTES, stream, a);
}
```

```cpp
#include <hip/hip_runtime.h>
#include <cstdio>
#include <cstdint>
#include <cmath>

typedef _Float16 half_t;
typedef _Float16 h2_t __attribute__((ext_vector_type(2)));
typedef _Float16 h4_t __attribute__((ext_vector_type(4)));
typedef float f32x2 __attribute__((ext_vector_type(2)));
typedef float f32x4 __attribute__((ext_vector_type(4)));

constexpr int D_MODEL = 2048, BATCH = 4, SEQ = 2048, T = BATCH * SEQ;
constexpr int HEAD_DIM = 64, ATT_WIDTH = 1024, ATT_HEADS = 16, ATT_KV_HEADS = 4, KV_WIDTH = 256, WINDOW = 128;
constexpr int SG_WIDTH = 1024, SG_GROUPS = 8, SG_CHUNK = 128;
constexpr int OFF_Q = 0, OFF_K = 1024, OFF_V = 1280, OFF_U = 1536, OFF_S = 2560, OFF_G = 3584, IN_COLS = 7680;
constexpr int N_GROUPS = 8, EPG = 8, N_EXPERTS = 64, EXPERT_FF = 512;
constexpr float EPS = 1e-6f;

constexpr size_t MiB = 1u << 20;
constexpr size_t WS_CTL = 0, CTL_ZERO_BYTES = 64 * 1024;
constexpr size_t WS_COSSIN = 1 * MiB;
constexpr size_t WS_ROUTEW = 2 * MiB;
constexpr size_t WS_LIST = 3 * MiB;
constexpr size_t WS_SGW = 5 * MiB;
constexpr size_t WS_WBR = 8 * MiB, WS_WOUT = 16 * MiB, WS_WIN = 24 * MiB;
constexpr size_t WS_XN = 54 * MiB;
constexpr size_t WS_AS = 86 * MiB;
constexpr size_t WS_MERGED = 118 * MiB;
constexpr size_t WS_PROJ = 150 * MiB;
constexpr size_t WS_HID = 270 * MiB;
constexpr size_t WS_Y2 = 288 * MiB;
constexpr size_t WS_WGU = 352 * MiB, WS_WD = 608 * MiB;
constexpr size_t WS_QN = 736 * MiB;
constexpr size_t WS_KN = 768 * MiB;
constexpr size_t WS_END = 776 * MiB;
constexpr int CW_CNT = 1024;

__device__ __forceinline__ float wave_sum(float v) {
#pragma unroll
    for (int o = 1; o < 64; o <<= 1) v += __shfl_xor(v, o);
    return v;
}
__device__ __forceinline__ float wave_max(float v) {
#pragma unroll
    for (int o = 1; o < 64; o <<= 1) v = fmaxf(v, __shfl_xor(v, o));
    return v;
}
__device__ __forceinline__ float gelu_tanh(float x) {
    const float u = 0.7978845608028654f * (x + 0.044715f * x * x * x);
    return x / (1.f + __expf(-2.f * u));
}
__device__ __forceinline__ float sigmoidf_(float x) { return 1.f / (1.f + __expf(-x)); }

#define LAS __attribute__((address_space(3)))
#define GAS __attribute__((address_space(1)))
typedef _Float16 h8_t __attribute__((ext_vector_type(8)));
typedef unsigned u32x4 __attribute__((ext_vector_type(4)));
typedef unsigned u32x2 __attribute__((ext_vector_type(2)));
typedef float f32x16 __attribute__((ext_vector_type(16)));
typedef short s16x4 __attribute__((ext_vector_type(4)));
typedef int i32x4 __attribute__((ext_vector_type(4)));
__device__ __forceinline__ __amdgpu_buffer_rsrc_t mk_rsrc(const void* p, unsigned bytes) { return __builtin_amdgcn_make_buffer_rsrc((void*)p, (short)0, (int)bytes, 0x00020000); }
__device__ __forceinline__ void st16_wt(__amdgpu_buffer_rsrc_t r, unsigned byte_off, u32x4 v) { __builtin_amdgcn_raw_buffer_store_b128(v, r, byte_off, 0, 16); }

constexpr size_t WS_RSTD2 = 2 * MiB + 128 * 1024;
constexpr size_t WS_ROWSS = 6 * MiB;
constexpr size_t WS_WRT = 7 * MiB;
constexpr size_t WS_XN8 = WS_WGU;
constexpr size_t WS_W8 = WS_WGU + 16 * MiB;
constexpr size_t WS_SA = 2 * MiB + 192 * 1024;
constexpr size_t WS_SW = 2 * MiB + 224 * 1024;
constexpr size_t WS_RSE = WS_XN;
constexpr size_t WS_RWE = WS_XN + 2 * MiB;
constexpr size_t WS_G8 = 400 * MiB;
constexpr size_t WS_H16 = WS_QN;
constexpr int NWAVES = 8;
constexpr int RING_BYTES = 131072, MISC_OFF = 147456, LDS_BYTES = 151552;
constexpr int MI_BAR = 0, MI_MT = 16, MI_OFFS = 144, MI_CNT = 208, MI_NT = 272, MI_SW = 280;
constexpr int CW_BAR = 4096, CW_CNT2 = 8192;

__device__ __forceinline__ unsigned pkh(float lo, float hi) { f32x2 v = {lo, hi}; h2_t h = __builtin_convertvector(v, h2_t); return __builtin_bit_cast(unsigned, h); }
__device__ __forceinline__ unsigned pk4_fp8(float a, float b, float c, float d) { int w = 0; w = __builtin_amdgcn_cvt_pk_fp8_f32(a, b, w, false); w = __builtin_amdgcn_cvt_pk_fp8_f32(c, d, w, true); return (unsigned)w; }
__device__ __forceinline__ float fast_exp2(float x) { return __builtin_amdgcn_exp2f(x); }
__device__ __forceinline__ float fast_rcp(float x) { return __builtin_amdgcn_rcpf(x); }
__device__ __forceinline__ float gelu_f(float x) { const float u = x + 0.044715f * x * x * x; return x * fast_rcp(1.f + fast_exp2(-2.302208198f * u)); }
__device__ __forceinline__ float sigm_f(float x) { return fast_rcp(1.f + fast_exp2(-1.4426950409f * x)); }

#define XB_TMO      128
#define XB_XCNT(j)  (256  + 64 * (j))
#define XB_XSUB(j)  (1280 + 64 * (j))
#define XB_XGEN(j)  (2304 + 64 * (j))
#define XB_TOP      3328
#define XB_TOPGEN   3392
#define XCD_BAR_WORDS 3456
#define XB_SPIN_CAP (1u << 18)
__device__ __forceinline__ unsigned xb_ld(unsigned* p)              { return __hip_atomic_load(p, __ATOMIC_RELAXED, __HIP_MEMORY_SCOPE_AGENT); }
__device__ __forceinline__ unsigned xb_add(unsigned* p, unsigned v) { return __hip_atomic_fetch_add(p, v, __ATOMIC_RELAXED, __HIP_MEMORY_SCOPE_AGENT); }
__device__ __forceinline__ unsigned xb_xcc_id() { return (unsigned)__builtin_amdgcn_s_getreg((3 << 11) | 20) & 0xFu; }
#define XB_SPIN(cond, bar) do { unsigned _sp = 0; while (cond) { __builtin_amdgcn_s_sleep(1); \
    if ((++_sp & 255u) == 0u) { if (xb_ld(&(bar)[XB_TMO])) break; if (_sp > XB_SPIN_CAP) { atomicAdd(&(bar)[XB_TMO], 1u); break; } } } } while (0)
struct XcdBarrier { unsigned* bar; unsigned x; volatile LAS unsigned* st; };
__device__ __forceinline__ XcdBarrier xcd_barrier_post(unsigned* bar, volatile LAS unsigned* st) {
    XcdBarrier b; b.bar = bar; b.x = xb_xcc_id(); b.st = st;
    if (threadIdx.x == 0) (void)xb_add(&bar[XB_XCNT(b.x)], 1u);
    return b;
}
__device__ __forceinline__ void xcd_barrier_complete(unsigned* bar, unsigned x, unsigned& nloc, unsigned& nx) {
    const unsigned G = gridDim.x * gridDim.y * gridDim.z;
    unsigned sum, cnt, mine, sp = 0u;
    for (;;) {
        sum = 0u; cnt = 0u; mine = 0u;
#pragma unroll
        for (unsigned j = 0; j < 16; ++j) { const unsigned c = xb_ld(&bar[XB_XCNT(j)]); sum += c; cnt += (c > 0u) ? 1u : 0u; mine = (j == x) ? c : mine; }
        if (sum == G) break;
        __builtin_amdgcn_s_sleep(1);
        if ((++sp & 255u) == 0u) { if (xb_ld(&bar[XB_TMO])) break; if (sp > XB_SPIN_CAP) { atomicAdd(&bar[XB_TMO], 1u); break; } }
    }
    nloc = mine > 0u ? mine : 1u; nx = cnt > 0u ? cnt : 1u;
}
__device__ __forceinline__ void xcd_barrier(const XcdBarrier& b) {
    asm volatile("s_waitcnt vmcnt(0)" ::: "memory");
    __syncthreads();
    if (threadIdx.x == 0) {
        unsigned* bar = b.bar;
        __builtin_amdgcn_s_waitcnt(0);
        unsigned nloc = b.st[0], nx = b.st[1];
        if (nloc == 0u) { xcd_barrier_complete(bar, b.x, nloc, nx); b.st[0] = nloc; b.st[1] = nx; }
        const unsigned old = xb_add(&bar[XB_XSUB(b.x)], 1u);
        const unsigned gen = old / nloc;
        if (old + 1u == (gen + 1u) * nloc) {
            __builtin_amdgcn_fence(__ATOMIC_RELEASE, "agent");
            asm volatile("s_waitcnt vmcnt(0)" ::: "memory");
            const unsigned og = xb_add(&bar[XB_TOP], 1u);
            const unsigned tg = og / nx;
            if (og + 1u == (tg + 1u) * nx) xb_add(&bar[XB_TOPGEN], 1u);
            else XB_SPIN(xb_ld(&bar[XB_TOPGEN]) == tg, bar);
            __builtin_amdgcn_fence(__ATOMIC_ACQUIRE, "agent");
            xb_add(&bar[XB_XGEN(b.x)], 1u);
            asm volatile("s_waitcnt vmcnt(0)" ::: "memory");
        } else {
            XB_SPIN(xb_ld(&bar[XB_XGEN(b.x)]) == gen, bar);
            __builtin_amdgcn_fence(__ATOMIC_ACQUIRE, "agent");
            asm volatile("s_waitcnt vmcnt(0)" ::: "memory");
        }
    }
    __syncthreads();
}

namespace pg {
constexpr int BM = 256, BK = 64, HALF = 128, HTB = HALF * BK * 2, STAGE_BYTES = 8 * HTB;
__device__ __forceinline__ int lds_byte(int r, int c) { const int st = (r >> 4) * 2 + (c >> 5), rr = r & 15, cc = c & 31, ob = rr * 64 + cc * 2; return st * 1024 + (ob ^ (((ob >> 9) & 1) << 5)); }
__device__ __forceinline__ void stage_rc(int b, int& R, int& C) { const int st = b / 1024, sb = b % 1024, swz = sb ^ (((sb >> 9) & 1) << 5); R = (st >> 1) * 16 + swz / 64; C = (st & 1) * 32 + (swz % 64) / 2; }
__device__ __forceinline__ int perm32(int rho) { const int n = rho >> 4, i = rho & 15; return 8 * (i >> 2) + 4 * n + (i & 3); }
typedef f32x4 Acc[2][2][4][2];

template <class P, bool ALIGN_EPI>
__device__ __forceinline__ void gemm_phase(LAS unsigned char* lds, const P& S) {
    const int tid = threadIdx.x, wid = __builtin_amdgcn_readfirstlane(tid >> 6), lane = tid & 63, wr = wid >> 2, wc = wid & 3, fr = lane & 15, fq = lane >> 4;
    const int nt = S.nt;
    int R[2], C[2]; unsigned voffB[2][2];
#pragma unroll
    for (int i = 0; i < 2; ++i) { stage_rc(tid * 16 + i * 8192, R[i], C[i]); const int Rb = P::PERM ? ((R[i] & ~31) + perm32(R[i] & 31)) : R[i];
#pragma unroll
        for (int h = 0; h < 2; ++h) voffB[h][i] = (unsigned)(((h * HALF + Rb) * S.ldb + C[i]) * 2); }
    const unsigned ldsw = (unsigned)wid * 1024u;
    const int aoff = lds_byte(wr * 64 + fr, fq * 8), boff = lds_byte(wc * 32 + fr, fq * 8);
#define PG_SA(b, h) (((b) * 2 + (h)) * HTB)
#define PG_SB(b, h) ((4 + (b) * 2 + (h)) * HTB)
#define PG_STAGE(bufoff, gbase, voff) do { _Pragma("unroll") for (int _i = 0; _i < 2; ++_i) \
        __builtin_amdgcn_global_load_lds((const unsigned*)((const char*)(gbase) + (voff)[_i]), (LAS unsigned*)(lds + (bufoff) + ldsw + _i * 8192), 16, 0, 0); } while (0)
#define PG_LDA(dst, b, h) do { _Pragma("unroll") for (int m = 0; m < 4; ++m) _Pragma("unroll") for (int k = 0; k < 2; ++k) dst[m][k] = *(const LAS h8_t*)(lds + PG_SA(b, h) + aoff + m * 2048 + k * 1024); } while (0)
#define PG_LDB(dst, b, h) do { _Pragma("unroll") for (int n = 0; n < 2; ++n) _Pragma("unroll") for (int k = 0; k < 2; ++k) dst[n][k] = *(const LAS h8_t*)(lds + PG_SB(b, h) + boff + n * 2048 + k * 1024); } while (0)
#define PG_MMA(ai, bj, At, Bt) do { __builtin_amdgcn_s_setprio(1); _Pragma("unroll") for (int m = 0; m < 4; ++m) _Pragma("unroll") for (int n = 0; n < 2; ++n) _Pragma("unroll") for (int k = 0; k < 2; ++k) \
        { if constexpr (P::I8) acc[ai][bj][m][n] = __builtin_bit_cast(f32x4, __builtin_amdgcn_mfma_i32_16x16x64_i8(__builtin_bit_cast(i32x4, Bt[n][k]), __builtin_bit_cast(i32x4, At[m][k]), __builtin_bit_cast(i32x4, acc[ai][bj][m][n]), 0, 0, 0)); \
          else acc[ai][bj][m][n] = __builtin_amdgcn_mfma_f32_16x16x32_f16(Bt[n][k], At[m][k], acc[ai][bj][m][n], 0, 0, 0); } __builtin_amdgcn_s_setprio(0); } while (0)
#define PG_WAIT_V(n) asm volatile("s_waitcnt vmcnt(" #n ")" ::: "memory")
#define PG_WAIT_L(n) asm volatile("s_waitcnt lgkmcnt(" #n ")" ::: "memory")
#define PG_BAR __builtin_amdgcn_s_barrier()
#define PG_SCHED __builtin_amdgcn_sched_barrier(0)
    typename P::Unit cur, nxt; int ui = 0;
    if (!S.next(0, cur)) return;
    Acc acc;
#pragma unroll
    for (int a = 0; a < 2; ++a)
#pragma unroll
        for (int b = 0; b < 2; ++b)
#pragma unroll
            for (int m = 0; m < 4; ++m)
#pragma unroll
                for (int n = 0; n < 2; ++n) acc[a][b][m][n] = (f32x4){0.f, 0.f, 0.f, 0.f};
    h8_t At[4][2], B0[2][2], B1[2][2];
    unsigned voffA[2][2];
    const char* cA = S.a_ptr(cur); const char* cB = S.b_ptr(cur);
    S.a_voff(cur, R, C, voffA);
    constexpr size_t kstep = (size_t)(BK * 2);
    PG_STAGE(PG_SB(0, 0), cB, voffB[0]); PG_STAGE(PG_SB(0, 1), cB, voffB[1]); PG_STAGE(PG_SA(0, 0), cA, voffA[0]); PG_STAGE(PG_SA(0, 1), cA, voffA[1]);
    if (wr == 1) PG_BAR;
    PG_WAIT_V(2); PG_BAR;
    PG_STAGE(PG_SB(1, 0), cB + kstep, voffB[0]); PG_STAGE(PG_SA(1, 0), cA + kstep, voffA[0]); PG_STAGE(PG_SB(1, 1), cB + kstep, voffB[1]);
    PG_WAIT_V(6); PG_BAR;
    for (;;) {
        const bool has_next = S.next(ui + 1, nxt);
        const char* nA = has_next ? S.a_ptr(nxt) : cA; const char* nB = has_next ? S.b_ptr(nxt) : cB;
        for (int t = 0; t < nt; t += 2) {
            const bool last = (t == nt - 2);
            if (P::MIDT >= 0 && t == P::MIDT) S.mid(acc, cur, wr, wc, fr, fq);
            const char* a1 = cA + (size_t)(t + 1) * kstep;
            const char* a2 = last ? nA : cA + (size_t)(t + 2) * kstep; const char* b2 = last ? nB : cB + (size_t)(t + 2) * kstep;
            const char* a3 = a2 + kstep; const char* b3 = b2 + kstep;
            PG_LDB(B0, 0, 0); PG_LDB(B1, 0, 1); PG_SCHED; PG_LDA(At, 0, 0); PG_STAGE(PG_SA(1, 1), a1, voffA[1]);
            PG_WAIT_V(8); PG_WAIT_L(0); PG_BAR; PG_MMA(0, 0, At, B0); PG_MMA(0, 1, At, B1); PG_BAR; PG_SCHED;
            if (last && has_next) S.a_voff(nxt, R, C, voffA);
            PG_LDA(At, 0, 1); PG_STAGE(PG_SB(0, 0), b2, voffB[0]); PG_STAGE(PG_SB(0, 1), b2, voffB[1]); PG_STAGE(PG_SA(0, 0), a2, voffA[0]);
            PG_WAIT_V(8); PG_WAIT_L(0); PG_BAR; PG_MMA(1, 0, At, B0); PG_MMA(1, 1, At, B1); PG_BAR; PG_SCHED;
            PG_LDB(B0, 1, 0); PG_LDB(B1, 1, 1); PG_SCHED; PG_LDA(At, 1, 0); PG_STAGE(PG_SA(0, 1), a2, voffA[1]);
            PG_WAIT_V(8); PG_WAIT_L(0); PG_BAR; PG_MMA(0, 0, At, B0); PG_MMA(0, 1, At, B1); PG_BAR; PG_SCHED;
            PG_LDA(At, 1, 1); PG_STAGE(PG_SB(1, 0), b3, voffB[0]); PG_STAGE(PG_SB(1, 1), b3, voffB[1]); PG_STAGE(PG_SA(1, 0), a3, voffA[0]);
            PG_WAIT_V(8); PG_WAIT_L(0); PG_BAR; PG_MMA(1, 0, At, B0); PG_MMA(1, 1, At, B1); PG_BAR; PG_SCHED;
        }
        if constexpr (ALIGN_EPI) { if (wr == 0) PG_BAR; }
        S.epi(acc, cur, wr, wc, fr, fq);
        if (!has_next) break;
#pragma unroll
        for (int a = 0; a < 2; ++a)
#pragma unroll
            for (int b = 0; b < 2; ++b)
#pragma unroll
                for (int m = 0; m < 4; ++m)
#pragma unroll
                    for (int n = 0; n < 2; ++n) acc[a][b][m][n] = (f32x4){0.f, 0.f, 0.f, 0.f};
        cur = nxt; cA = nA; cB = nB; ++ui;
        if constexpr (ALIGN_EPI) { if (wr == 1) PG_BAR; }
    }
    PG_WAIT_V(0);
    if constexpr (!ALIGN_EPI) { if (wr == 0) PG_BAR; }
    PG_BAR;
#undef PG_SA
#undef PG_SB
#undef PG_STAGE
#undef PG_LDA
#undef PG_LDB
#undef PG_MMA
#undef PG_WAIT_V
#undef PG_WAIT_L
#undef PG_BAR
#undef PG_SCHED
}

struct DenseOrder {
    int nM, nN, nwg, G, c;
    __device__ void init(int M, int N, int G_, int c_) { nM = M / BM; nN = N / BM; nwg = nM * nN; G = G_; c = c_; }
    __device__ bool next(int i, int& pm, int& pn) const {
        const long L = (long)i * G + c; if (L >= nwg) return false;
        int wgid = (int)L; { const int q = nwg / 8, r = nwg % 8, xcd = wgid % 8, off = wgid / 8; wgid = (xcd < r ? xcd * (q + 1) : r * (q + 1) + (xcd - r) * q) + off; }
        const int nig = 8 * nN, gid = wgid / nig, fm = gid * 8, gsz = (nM - fm) < 8 ? (nM - fm) : 8;
        pm = fm + ((wgid % nig) % gsz); pn = (wgid % nig) / gsz; return true;
    }
};
struct DUnit { int pm, pn; };
}

struct Frame {
    LAS unsigned char* lds; volatile LAS unsigned* MISC; unsigned* ctl;
    int tid, lane, wave, vcu, G;
    const float* in[22]; float* out; unsigned char* ws;
};

__host__ __device__ __forceinline__ bool attn_only_tile(int) { return true; }
__device__ __forceinline__ unsigned pk4_i8(float a, float b, float c, float d) {
    const int q0 = (int)__builtin_rintf(fminf(fmaxf(a, -127.f), 127.f)), q1 = (int)__builtin_rintf(fminf(fmaxf(b, -127.f), 127.f)), q2 = (int)__builtin_rintf(fminf(fmaxf(c, -127.f), 127.f)), q3 = (int)__builtin_rintf(fminf(fmaxf(d, -127.f), 127.f));
    return (unsigned)(q0 & 255) | ((unsigned)(q1 & 255) << 8) | ((unsigned)(q2 & 255) << 16) | ((unsigned)q3 << 24); }
struct ProjProbI8 {
    typedef pg::DUnit Unit; static constexpr bool I8 = true; static constexpr bool PERM = true; static constexpr int MIDT = -1;
    int nt, ldb; pg::DenseOrder ord; const unsigned char* A; const unsigned char* Bt; half_t* O; unsigned char* G8; const float* SA; float sW;
    __device__ __forceinline__ bool next(int i, Unit& u) const { return ord.next(i, u.pm, u.pn); }
    __device__ __forceinline__ const char* a_ptr(const Unit& u) const { return (const char*)A + (size_t)u.pm * 256 * D_MODEL; }
    __device__ __forceinline__ const char* b_ptr(const Unit& u) const { return (const char*)Bt + (size_t)u.pn * 256 * D_MODEL; }
    __device__ __forceinline__ void a_voff(const Unit&, const int (&R)[2], const int (&C)[2], unsigned (&v)[2][2]) const {
#pragma unroll
        for (int h = 0; h < 2; ++h)
#pragma unroll
            for (int i = 0; i < 2; ++i) v[h][i] = (unsigned)(((h * 128 + R[i]) * (D_MODEL / 2) + C[i]) * 2); }
    __device__ __forceinline__ void mid(pg::Acc&, const Unit&, int, int, int, int) const {}
    __device__ __forceinline__ void epi(pg::Acc& acc, const Unit& u, int wr, int wc, int fr, int fq) const {
        const bool gate = u.pn >= 14, gel = u.pn >= 6 && u.pn < 14;
        const int row0 = u.pm * 256 + wr * 64 + fr, col0 = u.pn * 256 + wc * 32 + 8 * fq;
        u32x2 hold[2];
        float scl[2][4];
#pragma unroll
        for (int ai = 0; ai < 2; ++ai)
#pragma unroll
            for (int m = 0; m < 4; ++m) scl[ai][m] = SA[row0 + ai * 128 + m * 16] * sW;
#pragma unroll
        for (int ai = 0; ai < 2; ++ai)
#pragma unroll
            for (int m = 0; m < 4; ++m) { const int row = row0 + ai * 128 + m * 16; half_t* rowp = O + (size_t)row * IN_COLS + col0; const float sc = scl[ai][m];
#pragma unroll
                for (int bj = 0; bj < 2; ++bj) { const i32x4 i0 = __builtin_bit_cast(i32x4, acc[ai][bj][m][0]), i1 = __builtin_bit_cast(i32x4, acc[ai][bj][m][1]);
                    f32x4 v0 = (f32x4){(float)i0[0], (float)i0[1], (float)i0[2], (float)i0[3]} * sc, v1 = (f32x4){(float)i1[0], (float)i1[1], (float)i1[2], (float)i1[3]} * sc;
                    if (gate) {
#pragma unroll
                        for (int e = 0; e < 4; ++e) { v0[e] = fminf(fmaxf(__builtin_rintf(sigm_f(v0[e]) * 255.f), 1.f), 255.f); v1[e] = fminf(fmaxf(__builtin_rintf(sigm_f(v1[e]) * 255.f), 1.f), 255.f); }
                        u32x2 wq; wq.x = (unsigned)v0[0] | ((unsigned)v0[1] << 8) | ((unsigned)v0[2] << 16) | ((unsigned)v0[3] << 24); wq.y = (unsigned)v1[0] | ((unsigned)v1[1] << 8) | ((unsigned)v1[2] << 16) | ((unsigned)v1[3] << 24);
                        if ((m & 1) == 0) { hold[bj] = wq; continue; }
                        { const u32x2 r0 = __builtin_amdgcn_permlane16_swap(hold[bj].x, wq.x, false, false), r1 = __builtin_amdgcn_permlane16_swap(hold[bj].y, wq.y, false, false);
                          u32x4 o4; o4.x = r0.x; o4.y = r1.x; o4.z = r0.y; o4.w = r1.y;
                          const bool odd = (fq & 1) != 0; const int rr = odd ? row : row - 16, cc = odd ? col0 - 8 : col0;
                          *(u32x4*)(G8 + (size_t)rr * (2 * D_MODEL) + (cc - OFF_G) + bj * 128) = o4; }
                        continue; }
                    else if (gel) {
#pragma unroll
                        for (int e = 0; e < 4; ++e) { v0[e] = gelu_f(v0[e]); v1[e] = gelu_f(v1[e]); } }
                    u32x4 w; w.x = pkh(v0[0], v0[1]); w.y = pkh(v0[2], v0[3]); w.z = pkh(v1[0], v1[1]); w.w = pkh(v1[2], v1[3]);
                    *(u32x4*)(rowp + bj * 128) = w; } }
    }
};

struct MergeProb {
    typedef pg::DUnit Unit; static constexpr bool I8 = false; static constexpr bool PERM = true; static constexpr int MIDT = 16;
    int nt, ldb; pg::DenseOrder ord; const half_t* A; const half_t* Bt; const unsigned char* G8; half_t* O;
    __device__ __forceinline__ bool next(int i, Unit& u) const { return ord.next(i, u.pm, u.pn); }
    __device__ __forceinline__ const char* a_ptr(const Unit& u) const { return (const char*)A + (size_t)u.pm * 256 * D_MODEL * 2; }
    __device__ __forceinline__ const char* b_ptr(const Unit& u) const { return (const char*)Bt + (size_t)u.pn * 256 * D_MODEL * 2; }
    __device__ __forceinline__ void a_voff(const Unit&, const int (&R)[2], const int (&C)[2], unsigned (&v)[2][2]) const {
#pragma unroll
        for (int h = 0; h < 2; ++h)
#pragma unroll
            for (int i = 0; i < 2; ++i) v[h][i] = (unsigned)(((h * 128 + R[i]) * D_MODEL + C[i]) * 2); }
    __device__ __forceinline__ void mid(pg::Acc& acc, const Unit& u, int wr, int wc, int fr, int fq) const {
        int row0 = u.pm * 256 + wr * 64 + fr; const int col0 = u.pn * 256 + wc * 32 + 8 * fq;
        asm volatile("" : "+v"(row0));
        u32x2 ga[2][2], gb[2][2];
#define MP_UB(w_, i_) ((float)(((i_) < 4 ? (w_).x >> (8 * (i_)) : (w_).y >> (8 * ((i_) - 4))) & 255u))
#define MP_LOADG(dst, g_) do { const unsigned char* gp_ = G8 + (size_t)(row0 + ((g_) >> 2) * 128 + ((g_) & 3) * 16) * (2 * D_MODEL) + col0; \
            _Pragma("unroll") for (int bj = 0; bj < 2; ++bj) { dst[bj][0] = *(const u32x2*)(gp_ + bj * 128); dst[bj][1] = *(const u32x2*)(gp_ + D_MODEL + bj * 128); } } while (0)
#define MP_SCALE(src, g_) do { const int ai = (g_) >> 2, m = (g_) & 3; _Pragma("unroll") for (int bj = 0; bj < 2; ++bj) { _Pragma("unroll") for (int e = 0; e < 4; ++e) { \
            acc[ai][bj][m][0][e] *= MP_UB(src[bj][0], e) * fast_rcp(MP_UB(src[bj][1], e)); acc[ai][bj][m][1][e] *= MP_UB(src[bj][0], 4 + e) * fast_rcp(MP_UB(src[bj][1], 4 + e)); } } } while (0)
        MP_LOADG(ga, 0);
#pragma unroll
        for (int g = 0; g < 8; g += 2) {
            MP_LOADG(gb, g + 1); asm volatile("" ::: "memory"); MP_SCALE(ga, g); asm volatile("" ::: "memory");
            if (g + 2 < 8) MP_LOADG(ga, g + 2); asm volatile("" ::: "memory"); MP_SCALE(gb, g + 1); asm volatile("" ::: "memory");
        }
#undef MP_SCALE
    }
    __device__ __forceinline__ void epi(pg::Acc& acc, const Unit& u, int wr, int wc, int fr, int fq) const {
        const int row0 = u.pm * 256 + wr * 64 + fr, col0 = u.pn * 256 + wc * 32 + 8 * fq;
        u32x2 ga[2][2], gb[2][2];
#define MP_STORE(src, g_) do { const int ai = (g_) >> 2, m = (g_) & 3; const size_t row = (size_t)(row0 + ai * 128 + m * 16); _Pragma("unroll") for (int bj = 0; bj < 2; ++bj) { \
            const u32x2 g1 = src[bj][1]; const f32x4 v0 = acc[ai][bj][m][0] * (1.f / 255.f), v1 = acc[ai][bj][m][1] * (1.f / 255.f); \
            u32x4 w; w.x = pkh(v0[0] * MP_UB(g1, 0), v0[1] * MP_UB(g1, 1)); w.y = pkh(v0[2] * MP_UB(g1, 2), v0[3] * MP_UB(g1, 3)); \
            w.z = pkh(v1[0] * MP_UB(g1, 4), v1[1] * MP_UB(g1, 5)); w.w = pkh(v1[2] * MP_UB(g1, 6), v1[3] * MP_UB(g1, 7)); \
            *(u32x4*)(O + row * D_MODEL + col0 + bj * 128) = w; } } while (0)
        MP_LOADG(ga, 0);
#pragma unroll
        for (int g = 0; g < 8; g += 2) {
            MP_LOADG(gb, g + 1); asm volatile("" ::: "memory"); MP_STORE(ga, g); asm volatile("" ::: "memory");
            if (g + 2 < 8) MP_LOADG(ga, g + 2); asm volatile("" ::: "memory"); MP_STORE(gb, g + 1); asm volatile("" ::: "memory");
        }
#undef MP_STORE
#undef MP_LOADG
#undef MP_UB
    }
};

struct OutProb {
    typedef pg::DUnit Unit; static constexpr bool I8 = false; static constexpr bool PERM = true; static constexpr int MIDT = -1;
    int nt, ldb; pg::DenseOrder ord; const half_t* A; const half_t* Bt; const float* x; const float* g2; float* out; half_t* H16; float* ROWSS;
    __device__ __forceinline__ bool next(int i, Unit& u) const { return ord.next(i, u.pm, u.pn); }
    __device__ __forceinline__ const char* a_ptr(const Unit& u) const { return (const char*)A + (size_t)u.pm * 256 * D_MODEL * 2; }
    __device__ __forceinline__ const char* b_ptr(const Unit& u) const { return (const char*)Bt + (size_t)u.pn * 256 * D_MODEL * 2; }
    __device__ __forceinline__ void a_voff(const Unit&, const int (&R)[2], const int (&C)[2], unsigned (&v)[2][2]) const {
#pragma unroll
        for (int h = 0; h < 2; ++h)
#pragma unroll
            for (int i = 0; i < 2; ++i) v[h][i] = (unsigned)(((h * 128 + R[i]) * D_MODEL + C[i]) * 2); }
    __device__ __forceinline__ void mid(pg::Acc&, const Unit&, int, int, int, int) const {}
    __device__ __forceinline__ void epi(pg::Acc& acc, const Unit& u, int wr, int wc, int fr, int fq) const {
        const int row0 = u.pm * 256 + wr * 64 + fr, col0 = u.pn * 256 + wc * 32 + 8 * fq;
        f32x4 gg[2][2];
#pragma unroll
        for (int bj = 0; bj < 2; ++bj)
#pragma unroll
            for (int n = 0; n < 2; ++n) gg[bj][n] = *(const f32x4*)(g2 + col0 + bj * 128 + n * 4);
        f32x4 xq[4][2][2];
#define OP_LOADX(dst, g_) do { const size_t r_ = (size_t)(row0 + ((g_) >> 2) * 128 + ((g_) & 3) * 16) * D_MODEL + col0; _Pragma("unroll") for (int bj = 0; bj < 2; ++bj) _Pragma("unroll") for (int n = 0; n < 2; ++n) dst[bj][n] = *(const f32x4*)(x + r_ + bj * 128 + n * 4); } while (0)
#define OP_GROUP(src, g_) do { const int ai = (g_) >> 2, m = (g_) & 3; const size_t row = (size_t)(row0 + ai * 128 + m * 16); float ss = 0.f; \
            _Pragma("unroll") for (int bj = 0; bj < 2; ++bj) { const size_t off = row * D_MODEL + col0 + bj * 128; \
                const f32x4 h0 = src[bj][0] + acc[ai][bj][m][0], h1 = src[bj][1] + acc[ai][bj][m][1]; \
                ss += ((h0[0] * h0[0] + h0[1] * h0[1]) + (h0[2] * h0[2] + h0[3] * h0[3])) + ((h1[0] * h1[0] + h1[1] * h1[1]) + (h1[2] * h1[2] + h1[3] * h1[3])); \
                u32x4 w; w.x = pkh(h0[0] * gg[bj][0][0], h0[1] * gg[bj][0][1]); w.y = pkh(h0[2] * gg[bj][0][2], h0[3] * gg[bj][0][3]); \
                w.z = pkh(h1[0] * gg[bj][1][0], h1[1] * gg[bj][1][1]); w.w = pkh(h1[2] * gg[bj][1][2], h1[3] * gg[bj][1][3]); *(u32x4*)(H16 + off) = w; } \
            ss += __shfl_xor(ss, 16); ss += __shfl_xor(ss, 32); if (fq == 0) ROWSS[row * 32 + u.pn * 4 + wc] = ss; } while (0)
#pragma unroll
        for (int g = 0; g < 4; ++g) OP_LOADX(xq[g], g);
        asm volatile("" ::: "memory");
#pragma unroll
        for (int g = 0; g < 8; ++g) {
            OP_GROUP(xq[g & 3], g); asm volatile("" ::: "memory");
            if (g + 4 < 8) OP_LOADX(xq[g & 3], g + 4); asm volatile("" ::: "memory");
        }
#undef OP_LOADX
#undef OP_GROUP
    }
};

template <bool Q8>
__device__ __forceinline__ void p0_item(const float* W, int N, void* dstv, int ldt, float qscale, LAS float* scr, int k0, int n0, int dst_row0, int lane) {
    { const int kk = lane >> 3, c4 = lane & 7;
      f32x4 v[8];
#pragma unroll
      for (int i = 0; i < 8; ++i) v[i] = *(const f32x4*)(W + (size_t)(k0 + 8 * i + kk) * N + n0 + 4 * c4);
#pragma unroll
      for (int i = 0; i < 8; ++i) { const f32x4 x = v[i]; LAS float* p = scr + (8 * i + kk) * 33 + 4 * c4; p[0] = x[0]; p[1] = x[1]; p[2] = x[2]; p[3] = x[3]; } }
    asm volatile("s_waitcnt lgkmcnt(0)" ::: "memory");
    const int c = lane & 7;
#pragma unroll
    for (int j = 0; j < 4; ++j) { const int n = (lane >> 3) + 8 * j; const LAS float* s = scr + (8 * c) * 33 + n;
        if constexpr (Q8) { u32x2 o; o.x = pk4_i8(s[0 * 33] * qscale, s[1 * 33] * qscale, s[2 * 33] * qscale, s[3 * 33] * qscale); o.y = pk4_i8(s[4 * 33] * qscale, s[5 * 33] * qscale, s[6 * 33] * qscale, s[7 * 33] * qscale);
            *(u32x2*)((unsigned char*)dstv + (size_t)(dst_row0 + n) * ldt + k0 + 8 * c) = o; }
        else { u32x4 o; o.x = pkh(s[0 * 33], s[1 * 33]); o.y = pkh(s[2 * 33], s[3 * 33]); o.z = pkh(s[4 * 33], s[5 * 33]); o.w = pkh(s[6 * 33], s[7 * 33]);
            *(u32x4*)((half_t*)dstv + (size_t)(dst_row0 + n) * ldt + k0 + 8 * c) = o; } }
    asm volatile("s_waitcnt lgkmcnt(0)" ::: "memory");
}
__device__ __forceinline__ void p0_prologue(Frame& F) {
    LAS float* scr = (LAS float*)(F.lds + F.wave * 16384);
    const int gw = F.vcu * NWAVES + F.wave, NGW = F.G * NWAVES, lane = F.lane;
    unsigned char* ws = F.ws;
    half_t* WIN_T = (half_t*)(ws + WS_WIN); unsigned char* W8 = ws + WS_W8;
    if (F.wave == 0) { float ss = 0.f;
#pragma unroll
        for (int r = 0; r < 2; ++r)
#pragma unroll
            for (int j = 0; j < 4; ++j) { const f32x4 v = *(const f32x4*)(F.in[3] + (size_t)r * IN_COLS + 4 * lane + 256 * j); ss += (v[0] * v[0] + v[1] * v[1]) + (v[2] * v[2] + v[3] * v[3]); }
        ss = wave_sum(ss); const float sw = 4.f * sqrtf(ss * (1.f / 2048.f)) * (1.f / 127.f);
        if (lane == 0) { ((LAS float*)F.MISC)[MI_SW] = sw; if (blockIdx.x == 0) *(float*)(ws + WS_SW) = sw; } }
    __syncthreads();
    const float inv_sw = 1.f / ((volatile LAS float*)F.MISC)[MI_SW];
    constexpr int I_IN = 32 * 240;
    for (int it = gw; it < I_IN; it += NGW) { const int kb = it / 240, nb = it % 240;
        if (attn_only_tile(nb >> 3)) p0_item<true>(F.in[3], IN_COLS, W8, D_MODEL, inv_sw, scr, 64 * kb, 32 * nb, 32 * nb, lane);
        else p0_item<false>(F.in[3], IN_COLS, WIN_T, D_MODEL, 1.f, scr, 64 * kb, 32 * nb, 32 * nb, lane); }
    { const float* x = F.in[0]; const float* g1 = F.in[2]; half_t* XN = (half_t*)(ws + WS_XN);
      for (int m = gw; m < T; m += 2 * NGW) { const int m2 = min(m + NGW, T - 1);
          const f32x4* xr = (const f32x4*)(x + (size_t)m * D_MODEL) + lane; const f32x4* xr2 = (const f32x4*)(x + (size_t)m2 * D_MODEL) + lane; f32x4 v[8], v2[8]; float s = 0.f, s2 = 0.f;
#pragma unroll
          for (int j = 0; j < 8; ++j) { v[j] = xr[64 * j]; v2[j] = xr2[64 * j]; }
#pragma unroll
          for (int j = 0; j < 8; ++j) { s += (v[j][0] * v[j][0] + v[j][1] * v[j][1]) + (v[j][2] * v[j][2] + v[j][3] * v[j][3]); s2 += (v2[j][0] * v2[j][0] + v2[j][1] * v2[j][1]) + (v2[j][2] * v2[j][2] + v2[j][3] * v2[j][3]); }
          const float r = rsqrtf(wave_sum(s) * (1.f / D_MODEL) + EPS), r2 = rsqrtf(wave_sum(s2) * (1.f / D_MODEL) + EPS);
          u32x2* o8 = (u32x2*)(XN + (size_t)m * D_MODEL) + lane; u32x2* o82 = (u32x2*)(XN + (size_t)m2 * D_MODEL) + lane;
          float am = 0.f, am2 = 0.f;
#pragma unroll
          for (int j = 0; j < 8; ++j) { const f32x4 g = ((const f32x4*)g1)[lane + 64 * j]; v[j] = v[j] * r * g; v2[j] = v2[j] * r2 * g;
              am = fmaxf(am, fmaxf(fmaxf(fabsf(v[j][0]), fabsf(v[j][1])), fmaxf(fabsf(v[j][2]), fabsf(v[j][3])))); am2 = fmaxf(am2, fmaxf(fmaxf(fabsf(v2[j][0]), fabsf(v2[j][1])), fmaxf(fabsf(v2[j][2]), fabsf(v2[j][3])))); }
          am = fmaxf(wave_max(am), 1e-20f); am2 = fmaxf(wave_max(am2), 1e-20f);
          const float qa = 127.f / am, qa2 = 127.f / am2;
          unsigned* q8 = (unsigned*)(ws + WS_XN8 + (size_t)m * D_MODEL) + lane; unsigned* q82 = (unsigned*)(ws + WS_XN8 + (size_t)m2 * D_MODEL) + lane;
#pragma unroll
          for (int j = 0; j < 8; ++j) { q8[64 * j] = pk4_i8(v[j][0] * qa, v[j][1] * qa, v[j][2] * qa, v[j][3] * qa); q82[64 * j] = pk4_i8(v2[j][0] * qa2, v2[j][1] * qa2, v2[j][2] * qa2, v2[j][3] * qa2); }
          if (lane == 0) { float* sa = (float*)(ws + WS_SA); sa[m] = am * (1.f / 127.f); sa[m2] = am2 * (1.f / 127.f); } } }

    { const int gt = gw * 64 + lane, NGT = NGW * 64; const int* pos = (const int*)F.in[1]; float* cs = (float*)(ws + WS_COSSIN);
      for (int i = gt; i < T * 8; i += NGT) { const int t = i >> 3, j = i & 7; const float inv = (float)pow(500000.0, -(double)j / 8.0); const float ang = (float)pos[t] * inv;
          cs[t * 16 + j] = (float)cos((double)ang); cs[t * 16 + 8 + j] = (float)sin((double)ang); } }
}
struct LcItem { const float* W; half_t* dst; int N, k0, n0, drow; };
__device__ __forceinline__ void lc_load(const LcItem& t, int lane, f32x4 (&v)[8]) { const int kk = lane >> 3, c4 = lane & 7;
#pragma unroll
    for (int i = 0; i < 8; ++i) v[i] = *(const f32x4*)(t.W + (size_t)(t.k0 + 8 * i + kk) * t.N + t.n0 + 4 * c4); }
__device__ __forceinline__ void lc_store(const LcItem& t, int lane, const f32x4 (&v)[8], LAS float* scr) { const int kk = lane >> 3, c4 = lane & 7;
#pragma unroll
    for (int i = 0; i < 8; ++i) { const f32x4 x = v[i]; LAS float* p = scr + (8 * i + kk) * 33 + 4 * c4; p[0] = x[0]; p[1] = x[1]; p[2] = x[2]; p[3] = x[3]; }
    asm volatile("s_waitcnt lgkmcnt(0)" ::: "memory");
    const int c = lane & 7;
#pragma unroll
    for (int j = 0; j < 4; ++j) { const int n = (lane >> 3) + 8 * j; const LAS float* s = scr + (8 * c) * 33 + n;
        u32x4 o; o.x = pkh(s[0 * 33], s[1 * 33]); o.y = pkh(s[2 * 33], s[3 * 33]); o.z = pkh(s[4 * 33], s[5 * 33]); o.w = pkh(s[6 * 33], s[7 * 33]);
        *(u32x4*)(t.dst + (size_t)(t.drow + n) * D_MODEL + t.k0 + 8 * c) = o; }
    asm volatile("s_waitcnt lgkmcnt(0)" ::: "memory"); }
__device__ __forceinline__ void late_weight_copies(Frame& F, int part, int nparts) {
    LAS float* scr = (LAS float*)(F.lds + F.wave * 16384);
    const int gw = part * NWAVES + F.wave, NGW = nparts * NWAVES, lane = F.lane;
    unsigned char* ws = F.ws;
    half_t* WBR_T = (half_t*)(ws + WS_WBR); half_t* WOUT_T = (half_t*)(ws + WS_WOUT); half_t* WRT = (half_t*)(ws + WS_WRT);
    constexpr int I_BR = 16 * 64, I_OUT = 32 * 64, I_WE = 32 * 2, NITEMS = 2 * I_BR + I_OUT + I_WE;
    auto decode = [&](int it) { LcItem t; int r = it < NITEMS ? it : NITEMS - 1;
        if (r < I_BR) { t.W = F.in[11]; t.dst = WBR_T; t.N = D_MODEL; t.k0 = 64 * (r / 64); t.n0 = 32 * (r % 64); t.drow = t.n0; return t; } r -= I_BR;
        if (r < I_BR) { t.W = F.in[12]; t.dst = WBR_T + 1024; t.N = D_MODEL; t.k0 = 64 * (r / 64); t.n0 = 32 * (r % 64); t.drow = t.n0; return t; } r -= I_BR;
        if (r < I_OUT) { t.W = F.in[13]; t.dst = WOUT_T; t.N = D_MODEL; t.k0 = 64 * (r / 64); t.n0 = 32 * (r % 64); t.drow = t.n0; return t; } r -= I_OUT;
        t.W = F.in[17]; t.dst = WRT; t.N = 64; t.k0 = 64 * (r / 2); t.n0 = 32 * (r % 2); t.drow = 8 + t.n0; return t; };
    f32x4 va[8], vb[8], vc[8];
    lc_load(decode(gw), lane, va); lc_load(decode(gw + NGW), lane, vb); lc_load(decode(gw + 2 * NGW), lane, vc);
    for (int it = gw; it < NITEMS; it += 3 * NGW) {
        lc_store(decode(it), lane, va, scr); lc_load(decode(it + 3 * NGW), lane, va);
        if (it + NGW < NITEMS) lc_store(decode(it + NGW), lane, vb, scr);
        lc_load(decode(it + 4 * NGW), lane, vb);
        if (it + 2 * NGW < NITEMS) lc_store(decode(it + 2 * NGW), lane, vc, scr);
        lc_load(decode(it + 5 * NGW), lane, vc);
    }
    { const int gt = gw * 64 + lane, NGT = NGW * 64; half_t* SGW = (half_t*)(ws + WS_SGW); const float* w = F.in[9];
      for (int i = gt; i < 8 * 128 * 128 / 8; i += NGT) { const f32x4 a = *(const f32x4*)(w + (size_t)i * 8), c = *(const f32x4*)(w + (size_t)i * 8 + 4);
          u32x4 o; o.x = pkh(a[0], a[1]); o.y = pkh(a[2], a[3]); o.z = pkh(c[0], c[1]); o.w = pkh(c[2], c[3]); *(u32x4*)(SGW + (size_t)i * 8) = o; }
      { float acc = 0.f;
        const float* pv[9] = {F.in[7], F.in[8], F.in[10], F.in[4], F.in[5], F.in[6], F.in[14], F.in[16], F.in[18]}; const int pn[9] = {1024, 1024, 1024, 64, 64, 16, 2048, 8, 64};
        f32x4 tv[9];
#pragma unroll
        for (int k = 0; k < 9; ++k) { tv[k] = (f32x4){0.f, 0.f, 0.f, 0.f}; if (gt < pn[k] / 4) tv[k] = ((const f32x4*)pv[k])[gt]; }
#pragma unroll
        for (int k = 0; k < 9; ++k) acc += tv[k][0];
        asm volatile("" :: "v"(acc)); } }
    { const int gt = gw * 64 + lane, NGT = NGW * 64; const float* wg = F.in[15];
      for (int i = gt; i < 8 * D_MODEL; i += NGT) { WRT[(size_t)(i & 7) * D_MODEL + (i >> 3)] = (half_t)wg[i]; WRT[(size_t)72 * D_MODEL + i] = (half_t)0.f; } }
}

namespace p2 {
constexpr int LDS_K = 0, LDS_V = 49152, LDS_WS = 98304;
constexpr int LDS_W = 0, W_STRIDE = 272, LDS_SC = 128 * W_STRIDE;
constexpr float C2 = 0.125f * 1.4426950408889634f;
__device__ __forceinline__ int crow(int r, int hi) { return (r & 3) + 8 * (r >> 2) + 4 * hi; }
__device__ __forceinline__ s16x4 vtr(const LAS unsigned char* p) { return __builtin_amdgcn_ds_read_tr16_b64_v4i16((LAS s16x4*)p); }
__device__ __forceinline__ h8_t vfrag(const LAS unsigned char* p_lo, const LAS unsigned char* p_hi) {
    const s16x4 lo = vtr(p_lo), hi = vtr(p_hi); typedef short s16x8 __attribute__((ext_vector_type(8)));
    const s16x8 v = {lo[0], lo[1], lo[2], lo[3], hi[0], hi[1], hi[2], hi[3]}; return __builtin_bit_cast(h8_t, v); }

__device__ __forceinline__ void qkt(f32x16& p0, f32x16& p1, const LAS unsigned char* Kt, const h8_t (&qr)[4], int r32, int hi) {
    const LAS unsigned char* kb = Kt + hi * 1024 + r32 * 16;
    p0 = (f32x16){}; p1 = (f32x16){};
#pragma unroll
    for (int d0 = 0; d0 < 4; ++d0) { const h8_t b0 = *(const LAS h8_t*)(kb + d0 * 2048), b1 = *(const LAS h8_t*)(kb + d0 * 2048 + 512);
        p0 = __builtin_amdgcn_mfma_f32_32x32x16_f16(b0, qr[d0], p0, 0, 0, 0); p1 = __builtin_amdgcn_mfma_f32_32x32x16_f16(b1, qr[d0], p1, 0, 0, 0); }
}
__device__ __forceinline__ void mask_tile(f32x16& p0, f32x16& p1, int tile, int ql, int hi, int klo, int khi) {
#pragma unroll
    for (int r = 0; r < 16; ++r) { const int k0 = 64 * tile + crow(r, hi), k1 = k0 + 32;
        const bool v0 = (k0 >= klo) && (k0 < khi) && (k0 - ql >= -WINDOW) && (k0 - ql <= WINDOW);
        const bool v1 = (k1 >= klo) && (k1 < khi) && (k1 - ql >= -WINDOW) && (k1 - ql <= WINDOW);
        p0[r] = v0 ? p0[r] : -1e30f; p1[r] = v1 ? p1[r] : -1e30f; }
}

__device__ __forceinline__ void attn_unit(Frame& F, int b, int qblk, int kvh) {
    const int tid = F.tid, lane = F.lane, wid = F.wave, r32 = lane & 31, hi = lane >> 5;
    const half_t* PROJ = (const half_t*)(F.ws + WS_PROJ); const float* cs = (const float*)(F.ws + WS_COSSIN); half_t* AS = (half_t*)(F.ws + WS_AS);
    const float* qg = F.in[4]; const float* kg = F.in[5]; const float* sink = F.in[6];
    LAS unsigned char* lds = F.lds;
    LAS int* kmx = (LAS int*)(lds + LDS_WS);
    if (tid == 0) *kmx = 0;
    __syncthreads();
    const int kpos0 = 128 * (qblk - 1);
    const int g = wid >> 1, h = kvh * 4 + g;
    const float sinkh = sink[h];
    float k2max = 0.f;
    const int c = tid & 7;
#pragma unroll
    for (int hb = 0; hb < 2; ++hb) {
        h8_t kr[3], vr[3]; f32x4 cc[3][4]; size_t trs[3];
#pragma unroll
        for (int i = 0; i < 3; ++i) { const int row = ((hb * 3 + i) * 512 + tid) >> 3;
            int kp = kpos0 + row; kp = (kp < 0 || kp >= SEQ) ? 0 : kp;
            const size_t trow = (size_t)b * SEQ + kp; trs[i] = trow;
            kr[i] = *(const h8_t*)(PROJ + trow * IN_COLS + OFF_K + kvh * 64 + c * 8);
            vr[i] = *(const h8_t*)(PROJ + trow * IN_COLS + OFF_V + kvh * 64 + c * 8);
#pragma unroll
            for (int q = 0; q < 4; ++q) cc[i][q] = *(const f32x4*)(cs + trow * 16 + 4 * q); }
#pragma unroll
        for (int i = 0; i < 3; ++i) { const int row = ((hb * 3 + i) * 512 + tid) >> 3;
            const h8_t kraw = kr[i], vraw = vr[i];
            float kf[8]; float ss = 0.f;
#pragma unroll
            for (int j = 0; j < 8; ++j) { kf[j] = (float)kraw[j]; ss += kf[j] * kf[j]; }
            ss += __shfl_xor(ss, 1); ss += __shfl_xor(ss, 2); ss += __shfl_xor(ss, 4);
            const float rn = rsqrtf(ss * (1.f / 64.f) + EPS);
            float s2 = 0.f;
#pragma unroll
            for (int j = 0; j < 8; ++j) { kf[j] = (kf[j] * rn) * kg[c * 8 + j]; s2 += kf[j] * kf[j]; }
            s2 += __shfl_xor(s2, 1); s2 += __shfl_xor(s2, 2); s2 += __shfl_xor(s2, 4);
            k2max = fmaxf(k2max, s2);
#pragma unroll
            for (int j = 0; j < 8; ++j) { const float partner = __shfl_xor(kf[j], 1); const float co = cc[i][j >> 2][j & 3], si = cc[i][2 + (j >> 2)][j & 3];
                const float rot = (c == 0) ? (kf[j] * co - partner * si) : (kf[j] * co + partner * si); kf[j] = (c < 2) ? rot : kf[j]; }
            u32x4 kw; kw.x = pkh(kf[0], kf[1]); kw.y = pkh(kf[2], kf[3]); kw.z = pkh(kf[4], kf[5]); kw.w = pkh(kf[6], kf[7]);
            *(LAS u32x4*)(lds + LDS_K + (row >> 6) * 8192 + c * 1024 + (row & 63) * 16) = kw;
            *(LAS h8_t*)(lds + LDS_V + (row >> 6) * 8192 + (c >> 2) * 4096 + ((row & 63) >> 3) * 512 + (row & 7) * 64 + (c & 3) * 16) = vraw; }
    }
    k2max = fmaxf(k2max, __shfl_xor(k2max, 8)); k2max = fmaxf(k2max, __shfl_xor(k2max, 16)); k2max = fmaxf(k2max, __shfl_xor(k2max, 32));
    if (lane == 0) atomicMax((int*)kmx, __float_as_int(k2max));
    __syncthreads();
    const float kmax2 = __int_as_float(*kmx);
    const int klo = (qblk == 0) ? 128 : 0, khi = (qblk == 15) ? 256 : 384;
    const float sk2 = sinkh * 1.4426950408889634f;
    const int vlane = ((lane >> 4) & 1) * 32 + (lane & 3) * 8 + (4 * hi + ((lane & 15) >> 2)) * 64;
    for (int i = 0; i < 2; ++i) {
        const int pb = 2 * (wid & 1) + i;
        const size_t tq0 = (size_t)b * SEQ + 128 * qblk + 32 * pb;
        const int ql = 128 + 32 * pb + r32;
        h8_t qr[4]; float mB;
        { const half_t* qp = PROJ + (tq0 + r32) * IN_COLS + OFF_Q + h * 64 + hi * 8; float qf[4][8]; float ss = 0.f;
#pragma unroll
          for (int d0 = 0; d0 < 4; ++d0) { const h8_t raw = *(const h8_t*)(qp + d0 * 16);
#pragma unroll
              for (int j = 0; j < 8; ++j) { qf[d0][j] = (float)raw[j]; ss += qf[d0][j] * qf[d0][j]; } }
          ss += __shfl_xor(ss, 32);
          const float rn = rsqrtf(ss * (1.f / 64.f) + EPS); float q2 = 0.f;
#pragma unroll
          for (int d0 = 0; d0 < 4; ++d0)
#pragma unroll
              for (int j = 0; j < 8; ++j) { qf[d0][j] = (qf[d0][j] * rn) * qg[d0 * 16 + hi * 8 + j]; q2 += qf[d0][j] * qf[d0][j]; }
          q2 += __shfl_xor(q2, 32);
          mB = sqrtf(q2 * kmax2) * C2 - 8.f;
#pragma unroll
          for (int j = 0; j < 8; ++j) { const float partner = __shfl_xor(qf[0][j], 32); const float co = cs[(tq0 + r32) * 16 + j], si = cs[(tq0 + r32) * 16 + 8 + j];
              qf[0][j] = (hi == 0) ? (qf[0][j] * co - partner * si) : (qf[0][j] * co + partner * si); }
#pragma unroll
          for (int d0 = 0; d0 < 4; ++d0) { u32x4 w; w.x = pkh(qf[d0][0] * C2, qf[d0][1] * C2); w.y = pkh(qf[d0][2] * C2, qf[d0][3] * C2); w.z = pkh(qf[d0][4] * C2, qf[d0][5] * C2); w.w = pkh(qf[d0][6] * C2, qf[d0][7] * C2);
              qr[d0] = __builtin_bit_cast(h8_t, w); } }
        const int t0 = pb >> 1;
        float l = 0.f; f32x16 o[2]; o[0] = (f32x16){}; o[1] = (f32x16){};
#define AT_TILE(D0, D1, EDGE) do { f32x16 p0, p1; p0 = (f32x16){}; p1 = (f32x16){}; \
            { const LAS unsigned char* kb = lds + LDS_K + tile * 8192 + hi * 1024 + r32 * 16; \
              _Pragma("unroll") for (int d0 = 0; d0 < 4; ++d0) { \
                  if (D0) { const h8_t b0 = *(const LAS h8_t*)(kb + d0 * 2048); p0 = __builtin_amdgcn_mfma_f32_32x32x16_f16(b0, qr[d0], p0, 0, 0, 0); } \
                  if (D1) { const h8_t b1 = *(const LAS h8_t*)(kb + d0 * 2048 + 512); p1 = __builtin_amdgcn_mfma_f32_32x32x16_f16(b1, qr[d0], p1, 0, 0, 0); } } } \
            if (EDGE) { _Pragma("unroll") for (int r = 0; r < 16; ++r) { const int d0 = 64 * tile + crow(r, hi) - ql, d1 = d0 + 32; \
                    if (D0) p0[r] = (d0 >= -WINDOW && d0 <= WINDOW) ? p0[r] : -1e30f; if (D1) p1[r] = (d1 >= -WINDOW && d1 <= WINDOW) ? p1[r] : -1e30f; } } \
            _Pragma("unroll") for (int r = 0; r < 16; ++r) { if (D0) { p0[r] = fast_exp2(p0[r] - mB); l += p0[r]; } if (D1) { p1[r] = fast_exp2(p1[r] - mB); l += p1[r]; } } \
            h8_t pa[4]; \
            { u32x4 w; \
              if (D0) { w.x = pkh(p0[0], p0[1]); w.y = pkh(p0[2], p0[3]); w.z = pkh(p0[4], p0[5]); w.w = pkh(p0[6], p0[7]); pa[0] = __builtin_bit_cast(h8_t, w); \
                        w.x = pkh(p0[8], p0[9]); w.y = pkh(p0[10], p0[11]); w.z = pkh(p0[12], p0[13]); w.w = pkh(p0[14], p0[15]); pa[1] = __builtin_bit_cast(h8_t, w); } \
              if (D1) { w.x = pkh(p1[0], p1[1]); w.y = pkh(p1[2], p1[3]); w.z = pkh(p1[4], p1[5]); w.w = pkh(p1[6], p1[7]); pa[2] = __builtin_bit_cast(h8_t, w); \
                        w.x = pkh(p1[8], p1[9]); w.y = pkh(p1[10], p1[11]); w.z = pkh(p1[12], p1[13]); w.w = pkh(p1[14], p1[15]); pa[3] = __builtin_bit_cast(h8_t, w); } } \
            const LAS unsigned char* vb = lds + LDS_V + tile * 8192 + vlane; \
              \
            _Pragma("unroll") for (int dh = 0; dh < 2; ++dh) \
                _Pragma("unroll") for (int ks = (D0) ? 0 : 2; ks < ((D1) ? 4 : 2); ++ks) { const h8_t vf = vfrag(vb + dh * 4096 + ks * 1024, vb + dh * 4096 + ks * 1024 + 512); \
                    o[dh] = __builtin_amdgcn_mfma_f32_32x32x16_f16(vf, pa[ks], o[dh], 0, 0, 0); } } while (0)
        const bool oddblk = (pb & 1) != 0;
#pragma unroll
        for (int tt = 0; tt < 5; ++tt) { const int tile = t0 + tt;
            if (64 * tile < klo || 64 * tile >= khi) continue;
            if (tt == 0) { if (oddblk) AT_TILE(false, true, true); else AT_TILE(true, true, true); }
            else if (tt == 4) { if (oddblk) AT_TILE(true, true, true); else AT_TILE(true, false, true); }
            else AT_TILE(true, true, false); }
#undef AT_TILE
        l += __shfl_xor(l, 32); l += fast_exp2(sk2 - mB);
        const float rl = fast_rcp(l);
        half_t* op = AS + (tq0 + r32) * 2048 + h * 64 + 8 * hi;
#pragma unroll
        for (int dh = 0; dh < 2; ++dh)
#pragma unroll
            for (int gp = 0; gp < 4; gp += 2) { u32x2 wa, wb;
                wa.x = pkh(o[dh][4 * gp] * rl, o[dh][4 * gp + 1] * rl); wa.y = pkh(o[dh][4 * gp + 2] * rl, o[dh][4 * gp + 3] * rl);
                wb.x = pkh(o[dh][4 * gp + 4] * rl, o[dh][4 * gp + 5] * rl); wb.y = pkh(o[dh][4 * gp + 6] * rl, o[dh][4 * gp + 7] * rl);
                const u32x2 r0 = __builtin_amdgcn_permlane32_swap(wa.x, wb.x, false, false), r1 = __builtin_amdgcn_permlane32_swap(wa.y, wb.y, false, false);
                u32x4 o4; o4.x = r0.x; o4.y = r1.x; o4.z = r0.y; o4.w = r1.y;
                *(u32x4*)(op + dh * 32 + gp * 8) = o4; }
    }
    __syncthreads();
}

__device__ __forceinline__ void sg_unit(Frame& F, int chunk, int g) {
    const int tid = F.tid, lane = F.lane, wid = F.wave, r32 = lane & 31, hi = lane >> 5;
    const half_t* PROJ = (const half_t*)(F.ws + WS_PROJ); half_t* AS = (half_t*)(F.ws + WS_AS);
    const float* lng = F.in[7]; const float* lnb = F.in[8]; const half_t* W = (const half_t*)(F.ws + WS_SGW) + (size_t)g * 128 * 128; const float* bs = F.in[10] + g * 128;
    LAS unsigned char* lds = F.lds;
    const size_t row0 = (size_t)chunk * 128;
    const int tb = wid >> 1, ch = wid & 1;
    const int t = tb * 32 + r32; const float bt = bs[t];
    h4_t uvv[2][4];
#pragma unroll
    for (int nt2 = 0; nt2 < 2; ++nt2) { const half_t* up = PROJ + (row0 + t) * IN_COLS + OFF_U + g * 128 + ch * 64 + nt2 * 32 + 4 * hi;
#pragma unroll
        for (int gq = 0; gq < 4; ++gq) uvv[nt2][gq] = *(const h4_t*)(up + gq * 8); }
    { const int row = tid >> 2, q4 = tid & 3;
      const u32x4* wp = (const u32x4*)(W + row * 128 + q4 * 32);
#pragma unroll
      for (int j = 0; j < 4; ++j) *(LAS u32x4*)(lds + LDS_W + row * W_STRIDE + q4 * 64 + j * 16) = wp[j];
      const half_t* sp = PROJ + (row0 + row) * IN_COLS + OFF_S + g * 128 + q4 * 32; float xv[32]; float s = 0.f;
#pragma unroll
      for (int j = 0; j < 4; ++j) { const h8_t raw = *(const h8_t*)(sp + j * 8);
#pragma unroll
          for (int e = 0; e < 8; ++e) { xv[j * 8 + e] = (float)raw[e]; s += xv[j * 8 + e]; } }
      s += __shfl_xor(s, 1); s += __shfl_xor(s, 2); const float mean = s * (1.f / 128.f); float qq = 0.f;
#pragma unroll
      for (int e = 0; e < 32; ++e) { xv[e] -= mean; qq += xv[e] * xv[e]; }
      qq += __shfl_xor(qq, 1); qq += __shfl_xor(qq, 2); const float rstd = rsqrtf(qq * (1.f / 128.f) + EPS);
      const float* gp = lng + g * 128 + q4 * 32; const float* bp = lnb + g * 128 + q4 * 32;
#pragma unroll
      for (int j = 0; j < 4; ++j) { float y[8];
#pragma unroll
          for (int e = 0; e < 8; ++e) y[e] = (xv[j * 8 + e] * rstd) * gp[j * 8 + e] + bp[j * 8 + e];
          u32x4 w; w.x = pkh(y[0], y[1]); w.y = pkh(y[2], y[3]); w.z = pkh(y[4], y[5]); w.w = pkh(y[6], y[7]);
          *(LAS u32x4*)(lds + LDS_SC + ((row >> 3) * 4 + q4) * 512 + (row & 7) * 64 + j * 16) = w; } }
    __syncthreads();
    f32x16 acc[2]; acc[0] = (f32x16){}; acc[1] = (f32x16){};
    const LAS unsigned char* wp2 = lds + LDS_W + (tb * 32 + r32) * W_STRIDE + hi * 16;
    const int blane = hi * 2048 + ((lane & 15) >> 2) * 64 + ((lane >> 4) & 1) * 32 + (lane & 3) * 8;
#pragma unroll
    for (int ks = 0; ks < 8; ++ks) { const h8_t wf = *(const LAS h8_t*)(wp2 + ks * 32);
#pragma unroll
        for (int nt2 = 0; nt2 < 2; ++nt2) { const LAS unsigned char* bp = lds + LDS_SC + (ks * 8 + (ch * 2 + nt2)) * 512 + blane;
            const h8_t sf = vfrag(bp, bp + 256); acc[nt2] = __builtin_amdgcn_mfma_f32_32x32x16_f16(sf, wf, acc[nt2], 0, 0, 0); } }
#pragma unroll
    for (int nt2 = 0; nt2 < 2; ++nt2) { const int c0 = ch * 64 + nt2 * 32 + 8 * hi; half_t* op = AS + (row0 + t) * 2048 + 1024 + g * 128 + c0;
#pragma unroll
        for (int gp = 0; gp < 4; gp += 2) { u32x2 wv[2];
#pragma unroll
            for (int q = 0; q < 2; ++q) { const int gq = gp + q; const h4_t uv = uvv[nt2][gq];
                wv[q].x = pkh((float)uv[0] * (acc[nt2][4 * gq] + bt), (float)uv[1] * (acc[nt2][4 * gq + 1] + bt)); wv[q].y = pkh((float)uv[2] * (acc[nt2][4 * gq + 2] + bt), (float)uv[3] * (acc[nt2][4 * gq + 3] + bt)); }
            const u32x2 r0 = __builtin_amdgcn_permlane32_swap(wv[0].x, wv[1].x, false, false), r1 = __builtin_amdgcn_permlane32_swap(wv[0].y, wv[1].y, false, false);
            u32x4 o4; o4.x = r0.x; o4.y = r1.x; o4.z = r0.y; o4.w = r1.y;
            *(u32x4*)(op + gp * 8) = o4; } }
    __syncthreads();
}
__device__ __forceinline__ void phase(Frame& F) {
    for (int u = F.vcu; u < 256; u += F.G) attn_unit(F, u >> 6, (u >> 2) & 15, u & 3);
    for (int u = F.vcu; u < 512; u += F.G) sg_unit(F, u >> 3, u & 7);
}
}

namespace mg {
#ifndef TEST_MT
#define TEST_MT 384
#endif
constexpr int MT = 384, BUFB = 16384, UMT = TEST_MT;
struct Unit { int e, m0, nrows, ns, rowbase; };
__device__ __forceinline__ void build_tables(Frame& F, const unsigned* cnt) {
    if (F.tid < 64) { const int e = F.tid; const unsigned c = cnt[e * 64]; const unsigned ntl = (c + (unsigned)UMT - 1u) / (unsigned)UMT;
        unsigned off = c, tp = ntl;
#pragma unroll
        for (int o = 1; o < 64; o <<= 1) { const unsigned a = __shfl_up(off, o), b2 = __shfl_up(tp, o); if (e >= o) { off += a; tp += b2; } }
        F.MISC[MI_CNT + e] = c; F.MISC[MI_OFFS + e] = off - c;
        for (unsigned j = 0; j < ntl; ++j) F.MISC[MI_MT + (tp - ntl) + j] = (unsigned)e | (j << 8);
        if (e == 63) F.MISC[MI_NT] = tp; }
    __syncthreads();
}
__device__ __forceinline__ bool get_unit(const volatile LAS unsigned* MISC, int idx, int ns_shift, Unit& u) {
    const int NT = (int)MISC[MI_NT]; const int mt = idx >> ns_shift; if (mt >= NT) return false;
    const unsigned ent = MISC[MI_MT + mt]; u.e = __builtin_amdgcn_readfirstlane((int)(ent & 0xffu)); const int j = __builtin_amdgcn_readfirstlane((int)(ent >> 8));
    u.ns = idx & ((1 << ns_shift) - 1); u.m0 = j * UMT;
    const int c = __builtin_amdgcn_readfirstlane((int)MISC[MI_CNT + u.e]); u.nrows = min(UMT, c - u.m0);
    u.rowbase = __builtin_amdgcn_readfirstlane((int)MISC[MI_OFFS + u.e]) + u.m0; return true;
}
typedef f32x4 Acc[3][8];
struct EpiPre { int a[3]; float f[3]; };
constexpr int LDS_BIMG = 0, LDS_ABUF = 3 * BUFB, ABUFB = MT * 128;
template <class P>
__device__ __forceinline__ void phase(LAS unsigned char* lds, const P& S) {
    const int tid = threadIdx.x, wid = __builtin_amdgcn_readfirstlane(tid >> 6), lane = tid & 63, fr = lane & 15, fq = lane >> 4;
    const int nt = S.nt, ldb = S.ldb;
    const int bk0 = tid >> 5, bn0 = (tid & 31) * 4;
    const int gofs0 = bk0 * ldb + (bn0 & 63);
    const int bch = (bn0 & 31) >> 2, bsl = (bch & 1) * 4 + (bch >> 1), bns = (bn0 & ~31) + bsl * 4;
    const int wofs0 = LDS_BIMG + ((bk0 >> 3) * 4 + (bns >> 5)) * 512 + (bk0 & 7) * 64 + ((((bns >> 4) & 1) ^ ((bk0 >> 3) & 1)) * 32) + (bns & 15) * 2;
    const bool seg1 = bn0 >= 64;
    const int achunk = tid & 7, arow0 = tid >> 3;
    const int awofs0 = LDS_ABUF + arow0 * 128 + ((achunk ^ (arow0 & 7)) * 16);
    const int q4 = (lane & 15) >> 2, p4 = lane & 3;
    const int lb0 = LDS_BIMG + fq * 2048 + q4 * 64 + p4 * 8 + ((fq & 1) * 32), lb1 = lb0 ^ 32;
    const int afo0 = LDS_ABUF + (wid * 16 + fr) * 128 + ((fq ^ (fr & 7)) * 16), afo1 = LDS_ABUF + (wid * 16 + fr) * 128 + (((4 + fq) ^ (fr & 7)) * 16);
    Unit u, un; int ui = 0;
    if (!S.next(0, u)) return;
    const half_t* abase = S.abase();
    const float* bp; const float* bpn = nullptr; bool hn = false; int aofs[6]; bool v3 = true, v3n = true;
    f32x4 St[2][4]; u32x4 As[6];
#define MG_KT(kt) (kt)
#define MG_SETUP(uu) do { bp = seg1 ? S.b1(uu) : S.b0(uu); v3n = (wid + 16) * 16 < (uu).nrows; \
        _Pragma("unroll") for (int i_ = 0; i_ < 6; ++i_) { const int row_ = 64 * i_ + arow0; aofs[i_] = S.aoff(uu, min(row_, (uu).nrows - 1)) + achunk * 8; } } while (0)
#define MG_LOADB(s, kt) do { const int kt_ = (kt); const bool ok_ = kt_ < nt;                  \
        const bool rl_ = ok_ || (P::RING && hn); const float* q_ = (P::RING && !ok_) ? bpn : bp; const int k_ = (P::RING && !ok_) ? kt_ - nt : kt_; \
        _Pragma("unroll") for (int i_ = 0; i_ < 4; ++i_) St[s][i_] = __builtin_nontemporal_load((const f32x4*)(q_ + (rl_ ? (size_t)(MG_KT(k_) * 64 + 16 * i_) * ldb + gofs0 : (size_t)0))); } while (0)
#define MG_LOADA(kt) do { const int kt_ = (kt); const bool ok_ = kt_ < nt; \
        _Pragma("unroll") for (int i_ = 0; i_ < 6; ++i_) As[i_] = *(const u32x4*)(abase + (ok_ ? aofs[i_] + MG_KT(kt_) * 64 : 0)); } while (0)
#define MG_WRITEB(s, bo) do { _Pragma("unroll") for (int i_ = 0; i_ < 4; ++i_) { u32x2 w_; w_.x = pkh(St[s][i_][0], St[s][i_][1]); w_.y = pkh(St[s][i_][2], St[s][i_][3]); *(LAS u32x2*)(lds + (bo) + wofs0 + 4096 * i_) = w_; } } while (0)
#define MG_WRITEA(ao) do { _Pragma("unroll") for (int i_ = 0; i_ < 6; ++i_) *(LAS u32x4*)(lds + (ao) + awofs0 + 8192 * i_) = As[i_]; } while (0)
#define MG_WRITEA_P(i0, i1, ao) do { _Pragma("unroll") for (int i_ = (i0); i_ < (i1); ++i_) *(LAS u32x4*)(lds + (ao) + awofs0 + 8192 * i_) = As[i_]; } while (0)
#define MG_AF(ks_, ao) do { _Pragma("unroll") for (int j_ = 0; j_ < 3; ++j_) af_[j_] = *(const LAS h8_t*)(lds + (ao) + ((ks_) ? afo1 : afo0) + j_ * 8 * 16 * 128); } while (0)
#define MG_GROUP(V2, ks_, hf_, bo) do { h8_t bf_[4]; \
            _Pragma("unroll") for (int n4_ = 0; n4_ < 4; ++n4_) { const int nf_ = (hf_) * 4 + n4_; const LAS unsigned char* p_ = lds + (bo) + ((nf_ & 1) ? lb1 : lb0) + (ks_) * 8192 + (nf_ >> 1) * 512; bf_[n4_] = p2::vfrag(p_, p_ + 256); } \
            _Pragma("unroll") for (int j_ = 0; j_ < 2; ++j_) { _Pragma("unroll") for (int n4_ = 0; n4_ < 4; ++n4_) acc[j_][(hf_) * 4 + n4_] = __builtin_amdgcn_mfma_f32_16x16x32_f16(bf_[n4_], af_[j_], acc[j_][(hf_) * 4 + n4_], 0, 0, 0); } \
            if (v3) { _Pragma("unroll") for (int n4_ = 0; n4_ < 4; ++n4_) acc[2][(hf_) * 4 + n4_] = __builtin_amdgcn_mfma_f32_16x16x32_f16(bf_[n4_], af_[2], acc[2][(hf_) * 4 + n4_], 0, 0, 0); } } while (0)
#define MG_SB __builtin_amdgcn_sched_barrier(0)
#define MG_BODY(V2, tt, s) do { const int bn_ = (bcur == 2 * BUFB) ? 0 : bcur + BUFB; const int an_ = acur ^ ABUFB; h8_t af_[3]; \
            MG_AF(0, acur); MG_GROUP(V2, 0, 0, bcur); MG_SB; \
            MG_WRITEA_P(0, 3, an_); MG_SB; \
            MG_GROUP(V2, 0, 1, bcur); MG_SB; \
            MG_WRITEA_P(3, 6, an_); MG_LOADA((tt) + 2); MG_SB; \
            MG_AF(1, acur); MG_GROUP(V2, 1, 0, bcur); MG_SB; \
            MG_WRITEB((s) ^ 1, bn_); MG_LOADB((s) ^ 1, (tt) + 3); MG_SB; \
            MG_GROUP(V2, 1, 1, bcur); \
            __syncthreads(); bcur = bn_; acur = an_; } while (0)
    MG_SETUP(u);
    MG_LOADA(0); __builtin_amdgcn_sched_barrier(0); MG_LOADB(0, 0); MG_LOADB(1, 1);
    int bcur = 0;
    if constexpr (P::RING) { bpn = bp; MG_WRITEB(0, 0); __builtin_amdgcn_sched_barrier(0); MG_LOADB(0, 2); }
    for (;;) {
        Acc acc;
#pragma unroll
        for (int j = 0; j < 3; ++j)
#pragma unroll
            for (int nf = 0; nf < 8; ++nf) acc[j][nf] = (f32x4){0.f, 0.f, 0.f, 0.f};
        v3 = v3n;
        if constexpr (P::RING) { Unit ut; hn = S.next(ui + 1, ut); bpn = hn ? (seg1 ? S.b1(ut) : S.b0(ut)) : bp; MG_WRITEA(0); MG_LOADA(1); }
        else { MG_WRITEB(0, 0); MG_WRITEA(0); MG_LOADA(1); __builtin_amdgcn_sched_barrier(0); MG_LOADB(0, 2); bcur = 0; }
        __builtin_amdgcn_sched_barrier(0);
        int pla = 0; float plf = 0.f; if constexpr (P::EARLY_PRE) S.epi_pre_lane(u, wid, fr, fq < 3 ? fq : 2, pla, plf);
        __syncthreads();
        int acur = 0;
#pragma unroll 1
            for (int t = 0; t < nt; t += 2) { MG_BODY(true, t, 0); MG_BODY(true, t + 1, 1); }
        const bool has_next = S.next(ui + 1, un);
        EpiPre pre;
        if constexpr (P::EARLY_PRE) {
#pragma unroll
            for (int j = 0; j < 3; ++j) { pre.a[j] = __shfl(pla, fr + 16 * j); pre.f[j] = __shfl(plf, fr + 16 * j); } }
        else S.epi_pre(u, wid, fr, pre);
        if (has_next) MG_SETUP(un);
        asm volatile("" : "+v"(pre.a[0]), "+v"(pre.a[1]), "+v"(pre.a[2]), "+v"(pre.f[0]), "+v"(pre.f[1]), "+v"(pre.f[2]));
        if (has_next) { MG_LOADA(0); __builtin_amdgcn_sched_barrier(0); if constexpr (!P::RING) { MG_LOADB(0, 0); MG_LOADB(1, 1); } }
        __builtin_amdgcn_sched_barrier(0);
        S.epi(acc, u, wid, fr, fq, pre);
        if (!has_next) break;
        u = un; ++ui;
    }
#undef MG_KT
#undef MG_SETUP
#undef MG_LOADB
#undef MG_LOADA
#undef MG_WRITEB
#undef MG_WRITEA
#undef MG_WRITEA_P
#undef MG_AF
#undef MG_GROUP
#undef MG_SB
#undef MG_BODY
}
}
struct GUProb {
    static constexpr bool EARLY_PRE = false, RING = false;
    int nt, ldb; const volatile LAS unsigned* MISC; int vcu, G; const half_t* H16; const float* Wg; const float* Wu; const int* LIST; const float* RSE; half_t* HID;
    __device__ __forceinline__ bool next(int i, mg::Unit& u) const { return mg::get_unit(MISC, vcu + i * G, 3, u); }
    __device__ __forceinline__ const float* b0(const mg::Unit& u) const { return Wg + ((size_t)u.e * D_MODEL * EXPERT_FF + u.ns * 64); }
    __device__ __forceinline__ const float* b1(const mg::Unit& u) const { return Wu + ((size_t)u.e * D_MODEL * EXPERT_FF + u.ns * 64); }
    __device__ __forceinline__ const half_t* abase() const { return H16; }
    __device__ __forceinline__ int aoff(const mg::Unit& u, int m) const { const int tok = LIST[u.e * 8192 + u.m0 + m] >> 1; return tok * D_MODEL; }
    __device__ __forceinline__ void epi_pre(const mg::Unit& u, int wid, int fr, mg::EpiPre& p) const {
#pragma unroll
        for (int j = 0; j < 3; ++j) { const int m = min((wid + 8 * j) * 16 + fr, u.nrows - 1); p.a[j] = 0; p.f[j] = RSE[u.e * 8192 + u.m0 + m]; }
    }
    __device__ __forceinline__ void epi_pre_lane(const mg::Unit& u, int wid, int fr, int j, int& a, float& f) const { const int m = min((wid + 8 * j) * 16 + fr, u.nrows - 1); a = 0; f = RSE[u.e * 8192 + u.m0 + m]; }
    __device__ __forceinline__ void epi(mg::Acc& acc, const mg::Unit& u, int wid, int fr, int fq, const mg::EpiPre& p) const {
#pragma unroll
        for (int j = 0; j < 3; ++j) { const int m = (wid + 8 * j) * 16 + fr;
            if (m < u.nrows) { const float r = p.f[j]; half_t* hp = HID + (size_t)(u.rowbase + m) * EXPERT_FF + u.ns * 64 + 8 * fq;
#pragma unroll
                for (int g = 0; g < 2; ++g) { u32x4 w;
#pragma unroll
                    for (int n = 0; n < 2; ++n) { f32x4 gt = acc[j][2 * g + n] * r; const f32x4 uu = acc[j][2 * g + n + 4] * r;
#pragma unroll
                        for (int e = 0; e < 4; ++e) gt[e] = gt[e] * sigm_f(gt[e]) * uu[e];
                        if (n == 0) { w.x = pkh(gt[0], gt[1]); w.y = pkh(gt[2], gt[3]); } else { w.z = pkh(gt[0], gt[1]); w.w = pkh(gt[2], gt[3]); } }
                    *(u32x4*)(hp + g * 32) = w; } } }
    }
};
struct DownProb {
    static constexpr bool EARLY_PRE = true, RING = true;
    int nt, ldb; const volatile LAS unsigned* MISC; int vcu, G; const half_t* HID; const float* Wd; const int* LIST; const float* RWE; unsigned char* Y2;
    __device__ __forceinline__ bool next(int i, mg::Unit& u) const { return mg::get_unit(MISC, vcu + i * G, 4, u); }
    __device__ __forceinline__ const float* b0(const mg::Unit& u) const { return Wd + (size_t)u.e * EXPERT_FF * D_MODEL + u.ns * 128; }
    __device__ __forceinline__ const float* b1(const mg::Unit& u) const { return Wd + (size_t)u.e * EXPERT_FF * D_MODEL + u.ns * 128 + 64; }
    __device__ __forceinline__ const half_t* abase() const { return HID; }
    __device__ __forceinline__ int aoff(const mg::Unit& u, int m) const { return (u.rowbase + m) * EXPERT_FF; }
    __device__ __forceinline__ void epi_pre(const mg::Unit& u, int wid, int fr, mg::EpiPre& p) const {
#pragma unroll
        for (int j = 0; j < 3; ++j) { const int m = min((wid + 8 * j) * 16 + fr, u.nrows - 1); p.a[j] = LIST[u.e * 8192 + u.m0 + m]; p.f[j] = RWE[u.e * 8192 + u.m0 + m]; }
    }
    __device__ __forceinline__ void epi_pre_lane(const mg::Unit& u, int wid, int fr, int j, int& a, float& f) const { const int m = min((wid + 8 * j) * 16 + fr, u.nrows - 1); a = LIST[u.e * 8192 + u.m0 + m]; f = RWE[u.e * 8192 + u.m0 + m]; }
    __device__ __forceinline__ void epi(mg::Acc& acc, const mg::Unit& u, int wid, int fr, int fq, const mg::EpiPre& p) const {
        const bool odd = (fq & 1) != 0;
#pragma unroll
        for (int j = 0; j < 3; ++j) { const int m = (wid + 8 * j) * 16 + fr; const float w8 = p.f[j];
            unsigned char* yp = Y2 + (size_t)p.a[j] * D_MODEL + u.ns * 128 + (odd ? 8 * (fq - 1) + 32 : 8 * fq);
#pragma unroll
            for (int gp = 0; gp < 4; gp += 2) { u32x2 wa, wb;
                { const f32x4 v0 = acc[j][2 * gp] * w8, v1 = acc[j][2 * gp + 1] * w8; wa.x = pk4_fp8(v0[0], v0[1], v0[2], v0[3]); wa.y = pk4_fp8(v1[0], v1[1], v1[2], v1[3]); }
                { const f32x4 v0 = acc[j][2 * gp + 2] * w8, v1 = acc[j][2 * gp + 3] * w8; wb.x = pk4_fp8(v0[0], v0[1], v0[2], v0[3]); wb.y = pk4_fp8(v1[0], v1[1], v1[2], v1[3]); }
                const u32x2 r0 = __builtin_amdgcn_permlane16_swap(wa.x, wb.x, false, false), r1 = __builtin_amdgcn_permlane16_swap(wa.y, wb.y, false, false);
                u32x4 o4; o4.x = r0.x; o4.y = r1.x; o4.z = r0.y; o4.w = r1.y;
                if (m < u.nrows) *(u32x4*)(yp + gp * 32) = o4; } }
    }
};

__device__ __forceinline__ void p5_router(Frame& F) {
    const int tid = F.tid, lane = F.lane, wid = F.wave, fr = lane & 15, fq = lane >> 4;
    const half_t* H16 = (const half_t*)(F.ws + WS_H16); const half_t* WRT = (const half_t*)(F.ws + WS_WRT); const float* ROWSS = (const float*)(F.ws + WS_ROWSS);
    float* RSTD2 = (float*)(F.ws + WS_RSTD2); float* RW = (float*)(F.ws + WS_ROUTEW); int* LIST = (int*)(F.ws + WS_LIST); unsigned* cnt = F.ctl + CW_CNT2;
    float* RSE = (float*)(F.ws + WS_RSE); float* RWE = (float*)(F.ws + WS_RWE);
    const float* bg = F.in[16]; const float* be = F.in[18];
    LAS float* LG = (LAS float*)F.lds;
    LAS float* RS = (LAS float*)(F.lds + 8 * 32 * 80 * 4);
    LAS float* BI = RS + 32;
    LAS unsigned* HI = (LAS unsigned*)(BI + 72);
    for (int blk = F.vcu; blk < T / 32; blk += F.G) {
        const int row0 = blk * 32;
        f32x4 acc[2][5];
#pragma unroll
        for (int m = 0; m < 2; ++m)
#pragma unroll
            for (int nf = 0; nf < 5; ++nf) acc[m][nf] = (f32x4){0.f, 0.f, 0.f, 0.f};
        const half_t* ap = H16 + (size_t)(row0 + fr) * D_MODEL + wid * 256 + fq * 8;
        const half_t* bp = WRT + (size_t)fr * D_MODEL + wid * 256 + fq * 8;
        h8_t af[4][2], bf[4][5];
#define P5_LOADH(half_) do { _Pragma("unroll") for (int k4 = 0; k4 < 4; ++k4) { const int kk = (half_) * 4 + k4; \
            _Pragma("unroll") for (int m = 0; m < 2; ++m) af[k4][m] = *(const h8_t*)(ap + (size_t)m * 16 * D_MODEL + kk * 32); \
            _Pragma("unroll") for (int nf = 0; nf < 5; ++nf) bf[k4][nf] = *(const h8_t*)(bp + (size_t)nf * 16 * D_MODEL + kk * 32); } } while (0)
#define P5_MMA() do { _Pragma("unroll") for (int k4 = 0; k4 < 4; ++k4) _Pragma("unroll") for (int m = 0; m < 2; ++m) _Pragma("unroll") for (int nf = 0; nf < 5; ++nf) \
            acc[m][nf] = __builtin_amdgcn_mfma_f32_16x16x32_f16(af[k4][m], bf[k4][nf], acc[m][nf], 0, 0, 0); } while (0)
        P5_LOADH(0);
        __builtin_amdgcn_sched_barrier(0);
        { const int row = tid >> 4, j = tid & 15; const float* rp = ROWSS + (size_t)(row0 + row) * 32 + 2 * j; float ss = rp[0] + rp[1];
          float bv = 0.f; if (tid < 72) bv = tid < 8 ? bg[tid] : be[tid - 8];
          ss += __shfl_xor(ss, 1); ss += __shfl_xor(ss, 2); ss += __shfl_xor(ss, 4); ss += __shfl_xor(ss, 8);
          if (j == 0) RS[row] = rsqrtf(ss * (1.f / D_MODEL) + EPS);
          if (tid < 72) BI[tid] = bv; if (tid < 64) HI[tid] = 0u; }
        __builtin_amdgcn_sched_barrier(0);
        P5_MMA();
        P5_LOADH(1);
        P5_MMA();
#undef P5_LOADH
#undef P5_MMA
#pragma unroll
        for (int m = 0; m < 2; ++m)
#pragma unroll
            for (int nf = 0; nf < 5; ++nf)
#pragma unroll
                for (int r = 0; r < 4; ++r) LG[(wid * 32 + m * 16 + fq * 4 + r) * 80 + nf * 16 + fr] = acc[m][nf][r];
        __syncthreads();
        for (int o = tid; o < 32 * 80; o += 512) LG[o] = ((LG[o] + LG[2560 + o]) + (LG[5120 + o] + LG[7680 + o])) + ((LG[10240 + o] + LG[12800 + o]) + (LG[15360 + o] + LG[17920 + o]));
        __syncthreads();
        if (tid < 64) { int ex0 = 0, ex1 = 0; unsigned r0 = 0u, r1 = 0u; float w0 = 0.f, w1 = 0.f, r = 0.f;
            if (tid < 32) { r = RS[tid];
                const LAS float* lg = LG + tid * 80;
                int grp = 0; float mx = lg[0] * r + BI[0]; float gl[8]; gl[0] = mx;
#pragma unroll
                for (int j = 1; j < 8; ++j) { gl[j] = lg[j] * r + BI[j]; if (gl[j] > mx) { mx = gl[j]; grp = j; } }
                float den = 0.f;
#pragma unroll
                for (int j = 0; j < 8; ++j) den += __expf(gl[j] - mx);
                const float gw = 1.f / den;
                float el[8];
#pragma unroll
                for (int j = 0; j < 8; ++j) el[j] = lg[8 + grp * 8 + j] * r + BI[8 + grp * 8 + j];
                int i0 = 0; float v0 = el[0];
#pragma unroll
                for (int j = 1; j < 8; ++j) if (el[j] > v0) { v0 = el[j]; i0 = j; }
                int i1 = 0; float v1 = -INFINITY;
#pragma unroll
                for (int j = 0; j < 8; ++j) if (j != i0 && el[j] > v1) { v1 = el[j]; i1 = j; }
                const float e1 = __expf(v1 - v0); w0 = gw / (1.f + e1); w1 = gw * e1 / (1.f + e1);
                ex0 = grp * 8 + i0; ex1 = grp * 8 + i1;
                r0 = __hip_atomic_fetch_add(HI + ex0, 1u, __ATOMIC_RELAXED, __HIP_MEMORY_SCOPE_WORKGROUP); r1 = __hip_atomic_fetch_add(HI + ex1, 1u, __ATOMIC_RELAXED, __HIP_MEMORY_SCOPE_WORKGROUP); }
            __builtin_amdgcn_fence(__ATOMIC_ACQ_REL, "wavefront");
            const unsigned c = HI[tid]; unsigned bse = 0u; if (c) bse = atomicAdd(&cnt[tid * 64], c);
            HI[tid] = bse;
            __builtin_amdgcn_fence(__ATOMIC_ACQ_REL, "wavefront");
            if (tid < 32) { const int t = row0 + tid; const unsigned p0 = HI[ex0] + r0, p1 = HI[ex1] + r1;
                LIST[ex0 * 8192 + p0] = t * 2; LIST[ex1 * 8192 + p1] = t * 2 + 1;
                RSE[ex0 * 8192 + p0] = r; RSE[ex1 * 8192 + p1] = r; RWE[ex0 * 8192 + p0] = w0; RWE[ex1 * 8192 + p1] = w1; } }
        __syncthreads();
    }
}
__device__ __forceinline__ void p8_combine(Frame& F) {
    const unsigned char* Y2 = F.ws + WS_Y2; const half_t* H16 = (const half_t*)(F.ws + WS_H16); const float* g2 = F.in[14]; float* out = F.out;
    const size_t gt = (size_t)(F.vcu * NWAVES + F.wave) * 64 + F.lane, NGT = (size_t)F.G * 512, NI = (size_t)T * D_MODEL / 8;
#define P8_LOAD(A_, B_, H_, GA_, GB_, i_) do { const size_t t_ = (i_) >> 8, c8_ = ((i_) & 255) * 8; A_ = *(const u32x2*)(Y2 + (t_ * 2) * D_MODEL + c8_); B_ = *(const u32x2*)(Y2 + (t_ * 2 + 1) * D_MODEL + c8_); \
        H_ = *(const h8_t*)(H16 + t_ * D_MODEL + c8_); GA_ = *(const f32x4*)(g2 + c8_); GB_ = *(const f32x4*)(g2 + c8_ + 4); } while (0)
    u32x2 a, b, an, bn; h8_t hh, hn; f32x4 ga, gb, gan, gbn;
    size_t i = gt;
    if (i < NI) P8_LOAD(a, b, hh, ga, gb, i);
    for (; i < NI; i += NGT) {
        const size_t inx = i + NGT;
        if (inx < NI) P8_LOAD(an, bn, hn, gan, gbn, inx);
        asm volatile("" ::: "memory");
        const size_t t = i >> 8, c8 = (i & 255) * 8;
        const f32x2 a0 = __builtin_amdgcn_cvt_pk_f32_fp8((int)a.x, false), a1 = __builtin_amdgcn_cvt_pk_f32_fp8((int)a.x, true), a2 = __builtin_amdgcn_cvt_pk_f32_fp8((int)a.y, false), a3 = __builtin_amdgcn_cvt_pk_f32_fp8((int)a.y, true);
        const f32x2 b0 = __builtin_amdgcn_cvt_pk_f32_fp8((int)b.x, false), b1 = __builtin_amdgcn_cvt_pk_f32_fp8((int)b.x, true), b2 = __builtin_amdgcn_cvt_pk_f32_fp8((int)b.y, false), b3 = __builtin_amdgcn_cvt_pk_f32_fp8((int)b.y, true);
        f32x4 o0, o1;
        o0[0] = (float)hh[0] * fast_rcp(ga[0]) + (a0[0] + b0[0]); o0[1] = (float)hh[1] * fast_rcp(ga[1]) + (a0[1] + b0[1]);
        o0[2] = (float)hh[2] * fast_rcp(ga[2]) + (a1[0] + b1[0]); o0[3] = (float)hh[3] * fast_rcp(ga[3]) + (a1[1] + b1[1]);
        o1[0] = (float)hh[4] * fast_rcp(gb[0]) + (a2[0] + b2[0]); o1[1] = (float)hh[5] * fast_rcp(gb[1]) + (a2[1] + b2[1]);
        o1[2] = (float)hh[6] * fast_rcp(gb[2]) + (a3[0] + b3[0]); o1[3] = (float)hh[7] * fast_rcp(gb[3]) + (a3[1] + b3[1]);
        f32x4* dp = (f32x4*)(out + t * D_MODEL + c8); dp[0] = o0; dp[1] = o1;
        asm volatile("" ::: "memory");
        a = an; b = bn; hh = hn; ga = gan; gb = gbn;
    }
#undef P8_LOAD
}
constexpr int N_PHASES = 9;
struct Args { const float* in[22]; float* out; unsigned char* ws; int ph_lo, ph_hi, use_bar, pad; };
__global__ void __launch_bounds__(NWAVES * 64, 2) mk_fwd(Args args) {
    extern __shared__ __attribute__((aligned(16))) unsigned char lds_raw[];
    Frame F;
    F.lds = (LAS unsigned char*)lds_raw; F.MISC = (volatile LAS unsigned*)(F.lds + MISC_OFF);
    F.tid = threadIdx.x; F.lane = F.tid & 63; F.wave = __builtin_amdgcn_readfirstlane(F.tid >> 6);
    F.G = gridDim.x; { const int bx = blockIdx.x; F.vcu = (F.G % 8 == 0) ? (bx % 8) * (F.G / 8) + bx / 8 : bx; }
#pragma unroll
    for (int i = 0; i < 22; ++i) F.in[i] = args.in[i];
    F.out = args.out; F.ws = args.ws; F.ctl = (unsigned*)(args.ws + WS_CTL);
    for (int u = F.tid; u < (LDS_BYTES - MISC_OFF) / 4; u += NWAVES * 64) ((LAS unsigned*)(F.lds + MISC_OFF))[u] = 0u;
    __syncthreads();
    XcdBarrier bar; bar.bar = F.ctl + CW_BAR; bar.x = 0; bar.st = nullptr;
    if (args.use_bar) bar = xcd_barrier_post(F.ctl + CW_BAR, F.MISC + MI_BAR);
    const int lo = args.ph_lo, hi = args.ph_hi;
#define IN(k) (lo <= (k) && (k) < hi)
#define SEAM(k) do { if (IN(k) && IN((k) + 1)) xcd_barrier(bar); } while (0)
    unsigned char* ws = args.ws;
    if (IN(0)) { p0_prologue(F); } SEAM(0);
    if (IN(1)) {
        { ProjProbI8 P; P.nt = 16; P.ldb = D_MODEL / 2; P.ord.init(T, 30 * 256, F.G, (int)blockIdx.x); P.A = ws + WS_XN8; P.Bt = ws + WS_W8; P.O = (half_t*)(ws + WS_PROJ); P.G8 = ws + WS_G8;
          P.SA = (const float*)(ws + WS_SA); P.sW = *(const float*)(ws + WS_SW);
          pg::gemm_phase<ProjProbI8, true>(F.lds, P); }
        { const int nwg = (T / 256) * 30, full = nwg % F.G;
          const int first = full ? full : 0, nparts = F.G - first;
          if ((int)blockIdx.x >= first) { __syncthreads(); late_weight_copies(F, (int)blockIdx.x - first, nparts); } } } SEAM(1);
    if (IN(2)) { p2::phase(F); } SEAM(2);
    if (IN(3)) { MergeProb P; P.nt = 32; P.ldb = D_MODEL; P.ord.init(T, D_MODEL, F.G, (int)blockIdx.x); P.A = (const half_t*)(ws + WS_AS); P.Bt = (const half_t*)(ws + WS_WBR); P.G8 = ws + WS_G8; P.O = (half_t*)(ws + WS_MERGED);
        pg::gemm_phase<MergeProb, true>(F.lds, P); } SEAM(3);
    if (IN(4)) { OutProb P; P.nt = 32; P.ldb = D_MODEL; P.ord.init(T, D_MODEL, F.G, (int)blockIdx.x); P.A = (const half_t*)(ws + WS_MERGED); P.Bt = (const half_t*)(ws + WS_WOUT); P.x = F.in[0]; P.g2 = F.in[14]; P.out = F.out;
        P.H16 = (half_t*)(ws + WS_H16); P.ROWSS = (float*)(ws + WS_ROWSS);
        pg::gemm_phase<OutProb, true>(F.lds, P); } SEAM(4);
    if (IN(5)) { p5_router(F); } SEAM(5);
    if (IN(6)) { mg::build_tables(F, F.ctl + CW_CNT2);
        GUProb P; P.nt = 32; P.ldb = EXPERT_FF; P.MISC = F.MISC; P.vcu = F.vcu; P.G = F.G; P.H16 = (const half_t*)(ws + WS_H16); P.Wg = F.in[19]; P.Wu = F.in[20]; P.LIST = (const int*)(ws + WS_LIST);
        P.RSE = (const float*)(ws + WS_RSE); P.HID = (half_t*)(ws + WS_HID);
        mg::phase<GUProb>(F.lds, P); } SEAM(6);
    if (IN(7)) { mg::build_tables(F, F.ctl + CW_CNT2);
        DownProb P; P.nt = 8; P.ldb = D_MODEL; P.MISC = F.MISC; P.vcu = F.vcu; P.G = F.G; P.HID = (const half_t*)(ws + WS_HID); P.Wd = F.in[21]; P.LIST = (const int*)(ws + WS_LIST);
        P.RWE = (const float*)(ws + WS_RWE); P.Y2 = ws + WS_Y2;
        mg::phase<DownProb>(F.lds, P); } SEAM(7);
    if (IN(8)) { p8_combine(F); }
#undef IN
#undef SEAM
}

extern "C" void kernel_launch(void* const* d_in, const int* in_sizes, int n_in, void* d_out, int out_size, void* d_ws, size_t ws_size, hipStream_t stream) {
    if (n_in != 22 || out_size != T * D_MODEL || ws_size < WS_END) { fprintf(stderr, "kernel_launch: unexpected shapes (n_in %d out %d ws %zu)\n", n_in, out_size, ws_size); return; }
    static int grid = 0;
    if (grid == 0) {
        int dev = 0, cus = 0;
        if (hipGetDevice(&dev) != hipSuccess || hipDeviceGetAttribute(&cus, hipDeviceAttributeMultiprocessorCount, dev) != hipSuccess) { fprintf(stderr, "kernel_launch: device query failed\n"); grid = -1; return; }
        if (hipFuncSetAttribute((const void*)mk_fwd, hipFuncAttributeMaxDynamicSharedMemorySize, LDS_BYTES) != hipSuccess) { fprintf(stderr, "kernel_launch: hipFuncSetAttribute failed\n"); grid = -1; return; }
        int per_cu = 0; (void)hipOccupancyMaxActiveBlocksPerMultiprocessor(&per_cu, (const void*)mk_fwd, NWAVES * 64, LDS_BYTES); (void)hipGetLastError();
        if (per_cu < 1) fprintf(stderr, "kernel_launch: occupancy query says %d blocks/CU\n", per_cu);
        grid = cus;
    }
    if (grid < 0) return;
    (void)hipMemsetAsync((unsigned char*)d_ws + WS_CTL, 0, CTL_ZERO_BYTES, stream);
    Args a{};
    for (int i = 0; i < 22; ++i) a.in[i] = (const float*)d_in[i];
    a.out = (float*)d_out; a.ws = (unsigned char*)d_ws; a.ph_lo = 0; a.ph_hi = N_PHASES; a.use_bar = 1;
    hipLaunchKernelGGL(mk_fwd, dim3(grid), dim3(NWAVES * 64), LDS_BYTES, stream, a);
}
```
